# Optimizing an MI355X kernel written in HIP

```python
import math
import jax, jax.numpy as jnp
from jax import lax
import numpy as np

D_MODEL = 1024
BATCH = 4
SEQ = 4096
DEPTH = 4

N_MIXERS = 2
HEAD_DIM = 64
N_ATTN_HEADS = D_MODEL // (2 * HEAD_DIM)
ATTN_QK_DIM = 2 * N_ATTN_HEADS * HEAD_DIM
ATTN_V_DIM = N_ATTN_HEADS * 2 * HEAD_DIM
NA_HEADS = D_MODEL // HEAD_DIM
GRID_W = 64
NA_KH = 8
NA_KW = 16
D_FF = 2816
CONV_W = 3
Q_BLOCK = 128
LN_EPS = 1e-5
RMS_EPS = 1e-5

kernel_name = "hybrid_diffattn_natten_convffn_deepnorm"


def layer_norm(x, g, b):
    xf = x.astype(jnp.float32)
    mu = jnp.mean(xf, axis=-1, keepdims=True)
    var = jnp.mean(jnp.square(xf - mu), axis=-1, keepdims=True)
    y = (xf - mu) * lax.rsqrt(var + LN_EPS) * g.astype(jnp.float32) + b.astype(jnp.float32)
    return y.astype(x.dtype)


def rms_norm(x, g):
    xf = x.astype(jnp.float32)
    y = xf * lax.rsqrt(jnp.mean(jnp.square(xf), axis=-1, keepdims=True) + RMS_EPS)
    return (y * g.astype(jnp.float32)).astype(x.dtype)


def alibi_slopes(n_heads):
    h = jnp.arange(1, n_heads + 1, dtype=jnp.float32)
    return jnp.exp2(-8.0 * h / n_heads)


def diff_attention(x, w_qkv, w_o, lam_vec, subln_g, lambda_init):
    B, S, _ = x.shape
    H, dh = N_ATTN_HEADS, HEAD_DIM
    qkv = x @ w_qkv
    q, k, v = jnp.split(qkv, [ATTN_QK_DIM, 2 * ATTN_QK_DIM], axis=-1)
    q = q.reshape(B, S, H, 2, dh) * (dh ** -0.5)
    k = k.reshape(B, S, H, 2, dh)
    v = v.reshape(B, S, H, 2 * dh)
    lf = lam_vec.astype(jnp.float32)
    lam = jnp.exp(jnp.sum(lf[0] * lf[1])) - jnp.exp(jnp.sum(lf[2] * lf[3])) + lambda_init
    slopes = alibi_slopes(H)
    pos = jnp.arange(S, dtype=jnp.float32)
    nb = S // Q_BLOCK
    q_blocks = jnp.transpose(q.reshape(B, nb, Q_BLOCK, H, 2, dh), (1, 0, 2, 3, 4, 5))
    q_pos = pos.reshape(nb, Q_BLOCK)

    def block(args):
        qb, qp = args
        s = jnp.einsum('bqhcd,bkhcd->bhcqk', qb, k).astype(jnp.float32)
        dist = jnp.abs(qp[:, None] - pos[None, :])
        s = s - slopes[None, :, None, None, None] * dist[None, None, None]
        p = jax.nn.softmax(s, axis=-1)
        a = p[:, :, 0] - lam * p[:, :, 1]
        return jnp.einsum('bhqk,bkhe->bqhe', a.astype(v.dtype), v)

    o = lax.map(block, (q_blocks, q_pos))
    o = jnp.transpose(o, (1, 0, 2, 3, 4)).reshape(B, S, H, 2 * dh)
    o = rms_norm(o, subln_g) * (1.0 - lambda_init)
    return o.reshape(B, S, H * 2 * dh) @ w_o


def neighborhood_attention(x, w_qkv, b_qkv, rpb, w_o, b_o):
    B, S, _ = x.shape
    rows = S // GRID_W
    kh = min(NA_KH, rows)
    kw = NA_KW
    H, dh = NA_HEADS, HEAD_DIM
    qkv = x @ w_qkv + b_qkv
    q, k, v = jnp.split(qkv, 3, axis=-1)
    q = q.reshape(B, rows, GRID_W, H, dh) * (dh ** -0.5)
    k = k.reshape(B, rows, GRID_W, H, dh)
    v = v.reshape(B, rows, GRID_W, H, dh)
    cols = jnp.arange(GRID_W, dtype=jnp.int32)
    col_start = jnp.clip(cols - kw // 2, 0, GRID_W - kw)
    col_idx = col_start[:, None] + jnp.arange(kw, dtype=jnp.int32)[None, :]
    col_off = col_idx - cols[:, None] + (NA_KW - 1)

    def row(r):
        r_start = jnp.clip(r - kh // 2, 0, rows - kh)
        k_rows = lax.dynamic_slice_in_dim(k, r_start, kh, axis=1)
        v_rows = lax.dynamic_slice_in_dim(v, r_start, kh, axis=1)
        k_sel = k_rows[:, :, col_idx]
        v_sel = v_rows[:, :, col_idx]
        q_row = lax.dynamic_index_in_dim(q, r, axis=1, keepdims=False)
        s = jnp.einsum('bchd,bicjhd->bhcij', q_row, k_sel).astype(jnp.float32)
        row_off = r_start + jnp.arange(kh, dtype=jnp.int32) - r + (NA_KH - 1)
        bias = rpb[:, row_off[None, :, None], col_off[:, None, :]]
        s = s + bias[None].astype(jnp.float32)
        p = jax.nn.softmax(s.reshape(B, H, GRID_W, kh * kw), axis=-1)
        p = p.reshape(B, H, GRID_W, kh, kw)
        return jnp.einsum('bhcij,bicjhd->bchd', p.astype(v.dtype), v_sel)

    o = lax.map(row, jnp.arange(rows, dtype=jnp.int32))
    o = jnp.transpose(o, (1, 0, 2, 3, 4)).reshape(B, S, H * dh)
    return o @ w_o + b_o


def conv_ffn(x, w_in, b_in, conv_w, conv_b, w_out, b_out):
    h = x @ w_in + b_in
    hp = jnp.pad(h, ((0, 0), (1, 1), (0, 0)))
    h = hp[:, :-2] * conv_w[0] + hp[:, 1:-1] * conv_w[1] + hp[:, 2:] * conv_w[2] + conv_b
    u, g = jnp.split(h, 2, axis=-1)
    return (u * jax.nn.gelu(g, approximate=False)) @ w_out + b_out


def setup_inputs(seed: int = 0) -> dict:
    key = jax.random.key(seed)
    ks = jax.random.split(key, 20)
    n_a = (DEPTH + 1) // 2
    n_b = DEPTH // 2
    beta = (8.0 * DEPTH) ** -0.25
    sd = D_MODEL ** -0.5
    nrm = jax.random.normal
    x = nrm(ks[0], (BATCH, SEQ, D_MODEL), jnp.float32)
    attn_w_qk = nrm(ks[1], (n_a, D_MODEL, 2 * ATTN_QK_DIM), jnp.float32) * sd
    attn_w_v = nrm(ks[2], (n_a, D_MODEL, ATTN_V_DIM), jnp.float32) * (sd * beta)
    attn_w_qkv = jnp.concatenate([attn_w_qk, attn_w_v], axis=-1)
    attn_w_o = nrm(ks[3], (n_a, ATTN_V_DIM, D_MODEL), jnp.float32) * (ATTN_V_DIM ** -0.5 * beta)
    attn_lambda = nrm(ks[4], (n_a, 4, HEAD_DIM), jnp.float32) * 0.1
    attn_subln_g = 1.0 + 0.02 * nrm(ks[5], (n_a, 2 * HEAD_DIM), jnp.float32)
    na_dim = NA_HEADS * HEAD_DIM
    na_w_qk = nrm(ks[6], (n_b, D_MODEL, 2 * na_dim), jnp.float32) * sd
    na_w_v = nrm(ks[7], (n_b, D_MODEL, na_dim), jnp.float32) * (sd * beta)
    na_w_qkv = jnp.concatenate([na_w_qk, na_w_v], axis=-1)
    na_b_qkv = 0.01 * nrm(ks[8], (n_b, 3 * na_dim), jnp.float32)
    na_rpb = 0.05 * nrm(ks[9], (n_b, NA_HEADS, 2 * NA_KH - 1, 2 * NA_KW - 1), jnp.float32)
    na_w_o = nrm(ks[10], (n_b, na_dim, D_MODEL), jnp.float32) * (na_dim ** -0.5 * beta)
    na_b_o = 0.01 * nrm(ks[11], (n_b, D_MODEL), jnp.float32)
    ffn_w_in = nrm(ks[12], (DEPTH, D_MODEL, 2 * D_FF), jnp.float32) * (sd * beta)
    ffn_b_in = 0.01 * nrm(ks[13], (DEPTH, 2 * D_FF), jnp.float32)
    ffn_conv_w = nrm(ks[14], (DEPTH, CONV_W, 2 * D_FF), jnp.float32) * (CONV_W ** -0.5)
    ffn_conv_b = 0.01 * nrm(ks[15], (DEPTH, 2 * D_FF), jnp.float32)
    ffn_w_out = nrm(ks[16], (DEPTH, D_FF, D_MODEL), jnp.float32) * (D_FF ** -0.5 * beta)
    ffn_b_out = 0.01 * nrm(ks[17], (DEPTH, D_MODEL), jnp.float32)
    ln_g = 1.0 + 0.02 * nrm(ks[18], (DEPTH, 2, D_MODEL), jnp.float32)
    ln_b = 0.02 * nrm(ks[19], (DEPTH, 2, D_MODEL), jnp.float32)
    return {"x": x, "attn_w_qkv": attn_w_qkv, "attn_w_o": attn_w_o,
            "attn_lambda": attn_lambda, "attn_subln_g": attn_subln_g,
            "na_w_qkv": na_w_qkv, "na_b_qkv": na_b_qkv, "na_rpb": na_rpb,
            "na_w_o": na_w_o, "na_b_o": na_b_o,
            "ffn_w_in": ffn_w_in, "ffn_b_in": ffn_b_in, "ffn_conv_w": ffn_conv_w,
            "ffn_conv_b": ffn_conv_b, "ffn_w_out": ffn_w_out, "ffn_b_out": ffn_b_out,
            "ln_g": ln_g, "ln_b": ln_b}


def reference(x, attn_w_qkv, attn_w_o, attn_lambda, attn_subln_g,
              na_w_qkv, na_b_qkv, na_rpb, na_w_o, na_b_o,
              ffn_w_in, ffn_b_in, ffn_conv_w, ffn_conv_b, ffn_w_out, ffn_b_out,
              ln_g, ln_b):
    alpha = (2.0 * DEPTH) ** 0.25
    for i in range(DEPTH):
        j = i // N_MIXERS
        if i % N_MIXERS == 0:
            lambda_init = 0.8 - 0.6 * math.exp(-0.3 * i)
            mix = diff_attention(x, attn_w_qkv[j], attn_w_o[j], attn_lambda[j],
                                 attn_subln_g[j], lambda_init)
        else:
            mix = neighborhood_attention(x, na_w_qkv[j], na_b_qkv[j], na_rpb[j],
                                         na_w_o[j], na_b_o[j])
        x = layer_norm(alpha * x + mix, ln_g[i, 0], ln_b[i, 0])
        ff = conv_ffn(x, ffn_w_in[i], ffn_b_in[i], ffn_conv_w[i], ffn_conv_b[i],
                      ffn_w_out[i], ffn_b_out[i])
        x = layer_norm(alpha * x + ff, ln_g[i, 1], ln_b[i, 1])
    return x
```

```cpp
#include <hip/hip_runtime.h>
#include <cstdio>
#include <cstdint>
namespace pg8 {
#define PG8_LAS __attribute__((address_space(3)))
typedef unsigned short bf16_t;
typedef short bf16x8 __attribute__((ext_vector_type(8)));
typedef float f32x4 __attribute__((ext_vector_type(4)));
typedef unsigned u32x4 __attribute__((ext_vector_type(4)));
constexpr int BM = 256, BK = 64, HALF = 128, HTB = HALF * BK * 2  , STAGE_BYTES = 8 * HTB, NXCD = 8, WGM = 8;

__host__ __device__ __forceinline__ int lds_byte(int r, int c) { const int st = (r >> 4) * 2 + (c >> 5), rr = r & 15, cc = c & 31, ob = rr * 64 + cc * 2; return st * 1024 + (ob ^ (((ob >> 9) & 1) << 5)); }
__host__ __device__ __forceinline__ void stage_rc(int b, int& R, int& C) { const int st = b / 1024, sb = b % 1024, swz = sb ^ (((sb >> 9) & 1) << 5); R = (st >> 1) * 16 + swz / 64; C = (st & 1) * 32 + (swz % 64) / 2; }
__host__ __device__ __forceinline__ int perm32(int rho) { const int n = rho >> 4, i = rho & 15; return 8 * (i >> 2) + 4 * n + (i & 3); }

struct Unit { int pm, pn; };
struct Gemm { const bf16_t* A; const bf16_t* Bt; int M, N, K; };

struct StaticOrder {
    int nM, nN, nwg, G, c;
    __host__ __device__ void init(int M, int N, int G_, int c_) { nM = M / BM; nN = N / BM; nwg = nM * nN; G = G_; c = c_; }
    __host__ __device__ bool next(int i, Unit& u) const {
        const long L = (long)i * G + c; if (L >= nwg) return false;
        int wgid = (int)L; { const int q = nwg / NXCD, r = nwg % NXCD, xcd = wgid % NXCD, off = wgid / NXCD; wgid = (xcd < r ? xcd * (q + 1) : r * (q + 1) + (xcd - r) * q) + off; }
        const int nig = WGM * nN, gid = wgid / nig, fm = gid * WGM, gsz = (nM - fm) < WGM ? (nM - fm) : WGM;
        u.pm = fm + ((wgid % nig) % gsz); u.pn = (wgid % nig) / gsz; return true;
    }
    __device__ __forceinline__ void a_ready(const Unit&) const {}
    __device__ __forceinline__ void done(const Unit&) const {}
};

__device__ __forceinline__ unsigned cvt_pk_bf16(float lo, float hi) { unsigned r; asm volatile("v_cvt_pk_bf16_f32 %0, %1, %2" : "=v"(r) : "v"(lo), "v"(hi)); return r; }
typedef float f32x2 __attribute__((ext_vector_type(2)));
__device__ __forceinline__ f32x2 gelu_pk(f32x2 v) {
    const f32x2 av = __builtin_elementwise_abs(v), d = av * 0.2316418882f + 1.0f;
    f32x2 t; t.x = __builtin_amdgcn_rcpf(d.x); t.y = __builtin_amdgcn_rcpf(d.y);
    f32x2 q = t * 0.5307027145f + (-0.7265760135f); q = q * t + 0.7107068705f; q = q * t + (-0.142248368f); q = q * t + 0.127414796f; q = q * t;
    const f32x2 s = (v * v) * (-0.72134752044f);
    f32x2 e; e.x = __builtin_amdgcn_exp2f(s.x); e.y = __builtin_amdgcn_exp2f(s.y);
    const f32x2 m = v * (q * e), r = v - m;
    f32x2 o; o.x = v.x < 0.f ? m.x : r.x; o.y = v.y < 0.f ? m.y : r.y; return o;
}

template <int ACT  > struct EpiBf16 {
    static constexpr bool PERM = true, AFTER_DRAIN = false; static_assert(ACT == 0 || ACT == 1, "EpiBf16: ACT is 0 (none) or 1 (gelu_pk)");
    bf16_t* O; int ldc; const float* bias; int split_cols; size_t split_stride; float scale0;
    __device__ __forceinline__ void operator()(const f32x4 (&acc)[2][2][4][2], const Unit& u, int wr, int wc, int fr, int fq) const {
        const int row0 = u.pm * BM + wr * 64 + fr; int colt = u.pn * BM; bf16_t* base = O;
        float sc = 1.f; if (split_cols) { const int t = colt / split_cols; base += (size_t)t * split_stride; colt -= t * split_cols; if (t == 0) sc = scale0; }
        const int col0 = colt + wc * 32 + 8 * fq, bcol0 = u.pn * BM + wc * 32 + 8 * fq;
        f32x4 bv[2][2];
#pragma unroll
        for (int bj = 0; bj < 2; ++bj)
#pragma unroll
            for (int n = 0; n < 2; ++n) bv[bj][n] = bias ? *(const f32x4*)(bias + bcol0 + bj * HALF + 4 * n) : (f32x4){0.f, 0.f, 0.f, 0.f};
#pragma unroll
        for (int ai = 0; ai < 2; ++ai)
#pragma unroll
            for (int m = 0; m < 4; ++m) { bf16_t* rowp = base + (size_t)(row0 + ai * HALF + m * 16) * ldc + col0;
#pragma unroll
                for (int bj = 0; bj < 2; ++bj) { f32x4 v0 = acc[ai][bj][m][0] + bv[bj][0], v1 = acc[ai][bj][m][1] + bv[bj][1];
                    if (ACT == 1) { f32x2 a = gelu_pk((f32x2){v0[0], v0[1]}), b = gelu_pk((f32x2){v0[2], v0[3]}), c = gelu_pk((f32x2){v1[0], v1[1]}), d = gelu_pk((f32x2){v1[2], v1[3]});
                        v0 = (f32x4){a.x, a.y, b.x, b.y}; v1 = (f32x4){c.x, c.y, d.x, d.y}; }
                    v0 = v0 * sc; v1 = v1 * sc; u32x4 w; w.x = cvt_pk_bf16(v0[0], v0[1]); w.y = cvt_pk_bf16(v0[2], v0[3]); w.z = cvt_pk_bf16(v1[0], v1[1]); w.w = cvt_pk_bf16(v1[2], v1[3]);
                    *(u32x4*)(rowp + bj * HALF) = w; } }
    }
};
struct EpiF32 {
    static constexpr bool PERM = false, AFTER_DRAIN = false;
    float* C; int ldc; const float* bias;
    __device__ __forceinline__ void operator()(const f32x4 (&acc)[2][2][4][2], const Unit& u, int wr, int wc, int fr, int fq) const {
        const int row0 = u.pm * BM + wr * 64 + fr, col0 = u.pn * BM + wc * 32 + 4 * fq;
        f32x4 bv[2][2];
#pragma unroll
        for (int bj = 0; bj < 2; ++bj)
#pragma unroll
            for (int n = 0; n < 2; ++n) bv[bj][n] = bias ? *(const f32x4*)(bias + col0 + bj * HALF + n * 16) : (f32x4){0.f, 0.f, 0.f, 0.f};
#pragma unroll
        for (int ai = 0; ai < 2; ++ai)
#pragma unroll
            for (int m = 0; m < 4; ++m) { float* rowp = C + (size_t)(row0 + ai * HALF + m * 16) * ldc + col0;
#pragma unroll
                for (int bj = 0; bj < 2; ++bj)
#pragma unroll
                    for (int n = 0; n < 2; ++n) *(f32x4*)(rowp + bj * HALF + n * 16) = acc[ai][bj][m][n] + bv[bj][n]; }
    }
};
template <class Epi, class Sched, bool ALIGN_EPI = false, bool SP2 = false>
__device__ __forceinline__ void gemm_phase(PG8_LAS unsigned char* lds, const Gemm g, const Sched& S, const Epi& E) {
    const int tid = threadIdx.x, wid = __builtin_amdgcn_readfirstlane(tid >> 6), lane = tid & 63, wr = wid >> 2, wc = wid & 3, fr = lane & 15, fq = lane >> 4;
    const int K = g.K, nt = K / BK;
    unsigned voffA[2], voffB[2];
#pragma unroll
    for (int i = 0; i < 2; ++i) { int R, C; stage_rc(tid * 16 + i * 8192, R, C); const int Rb = Epi::PERM ? ((R & ~31) + perm32(R & 31)) : R;
        voffA[i] = (unsigned)(R * K + C) * 2u; voffB[i] = (unsigned)(Rb * K + C) * 2u; }
    const size_t kstep = (size_t)(BK * 2);
    const size_t hstep = (size_t)HALF * K * 2;
    const size_t tstep = 2 * hstep;
    const unsigned ldsw = (unsigned)wid * 1024u;
    const int aoff = lds_byte(wr * 64 + fr, fq * 8), boff = lds_byte(wc * 32 + fr, fq * 8);
#define PG8_SA(b, h) (((b) * 2 + (h)) * HTB)
#define PG8_SB(b, h) ((4 + (b) * 2 + (h)) * HTB)
#define PG8_STAGE(bufoff, gbase, voff) do { _Pragma("unroll") for (int _i = 0; _i < 2; ++_i) \
        __builtin_amdgcn_global_load_lds((const unsigned*)((const char*)(gbase) + (voff)[_i]), (PG8_LAS unsigned*)(lds + (bufoff) + ldsw + _i * 8192), 16, 0, 0); } while (0)
#define PG8_LDA(dst, b, h) do { _Pragma("unroll") for (int m = 0; m < 4; ++m) _Pragma("unroll") for (int k = 0; k < 2; ++k) dst[m][k] = *(const PG8_LAS bf16x8*)(lds + PG8_SA(b, h) + aoff + m * 2048 + k * 1024); } while (0)
#define PG8_LDB(dst, b, h) do { _Pragma("unroll") for (int n = 0; n < 2; ++n) _Pragma("unroll") for (int k = 0; k < 2; ++k) dst[n][k] = *(const PG8_LAS bf16x8*)(lds + PG8_SB(b, h) + boff + n * 2048 + k * 1024); } while (0)
#define PG8_MMA(ai, bj, At, Bt) do { __builtin_amdgcn_s_setprio(1); _Pragma("unroll") for (int m = 0; m < 4; ++m) _Pragma("unroll") for (int n = 0; n < 2; ++n) _Pragma("unroll") for (int k = 0; k < 2; ++k) \
        acc[ai][bj][m][n] = __builtin_amdgcn_mfma_f32_16x16x32_bf16(Bt[n][k], At[m][k], acc[ai][bj][m][n], 0, 0, 0); __builtin_amdgcn_s_setprio(0); } while (0)
#define PG8_WAIT_V(n) asm volatile("s_waitcnt vmcnt(" #n ")" ::: "memory")
#define PG8_WAIT_L(n) asm volatile("s_waitcnt lgkmcnt(" #n ")" ::: "memory")
#define PG8_BAR __builtin_amdgcn_s_barrier()
#define PG8_SCHED __builtin_amdgcn_sched_barrier(0)
    Unit cur, nxt; int ui = 0;
    if (!S.next(0, cur)) return;
    f32x4 acc[2][2][4][2];
#pragma unroll
    for (int a = 0; a < 2; ++a)
#pragma unroll
        for (int b = 0; b < 2; ++b)
#pragma unroll
            for (int m = 0; m < 4; ++m)
#pragma unroll
                for (int n = 0; n < 2; ++n) acc[a][b][m][n] = (f32x4){0.f, 0.f, 0.f, 0.f};
    bf16x8 At[4][2], B0[2][2], B1[2][2];
    const char* cA = (const char*)g.A + (size_t)cur.pm * tstep; const char* cB = (const char*)g.Bt + (size_t)cur.pn * tstep;
    S.a_ready(cur);
    if constexpr (SP2) {
        PG8_STAGE(PG8_SB(0, 0), cB, voffB); PG8_STAGE(PG8_SB(0, 1), cB + hstep, voffB); PG8_STAGE(PG8_SA(0, 0), cA, voffA); PG8_STAGE(PG8_SA(0, 1), cA + hstep, voffA);
        if (wr == 1) PG8_BAR;
        PG8_WAIT_V(2); PG8_BAR;
        PG8_STAGE(PG8_SB(1, 0), cB + kstep, voffB); PG8_STAGE(PG8_SA(1, 0), cA + kstep, voffA); PG8_STAGE(PG8_SB(1, 1), cB + hstep + kstep, voffB);
        PG8_WAIT_V(6); PG8_BAR;
    } else {
        PG8_STAGE(PG8_SB(0, 0), cB, voffB); PG8_STAGE(PG8_SA(0, 0), cA, voffA); PG8_STAGE(PG8_SB(0, 1), cB + hstep, voffB); PG8_STAGE(PG8_SA(0, 1), cA + hstep, voffA);
        if (wr == 1) PG8_BAR;
        PG8_WAIT_V(4); PG8_BAR;
        PG8_STAGE(PG8_SB(1, 0), cB + kstep, voffB); PG8_STAGE(PG8_SA(1, 0), cA + kstep, voffA); PG8_STAGE(PG8_SB(1, 1), cB + hstep + kstep, voffB);
        PG8_WAIT_V(6); PG8_BAR;
    }
    for (;;) {
        const bool has_next = S.next(ui + 1, nxt);
        const char* nA = has_next ? (const char*)g.A + (size_t)nxt.pm * tstep : cA; const char* nB = has_next ? (const char*)g.Bt + (size_t)nxt.pn * tstep : cB;
        for (int t = 0; t < nt; t += 2) {
            const bool last = (t == nt - 2);
            const char* a1 = cA + (size_t)(t + 1) * kstep;
            const char* a2 = last ? nA : cA + (size_t)(t + 2) * kstep; const char* b2 = last ? nB : cB + (size_t)(t + 2) * kstep;
            const char* a3 = a2 + kstep; const char* b3 = b2 + kstep;
            if (last && has_next) S.a_ready(nxt);
            if constexpr (SP2) {
            PG8_LDB(B0, 0, 0); PG8_LDB(B1, 0, 1); PG8_SCHED; PG8_LDA(At, 0, 0); PG8_STAGE(PG8_SA(1, 1), a1 + hstep, voffA);
            PG8_WAIT_V(8); PG8_WAIT_L(0); PG8_BAR; PG8_MMA(0, 0, At, B0); PG8_MMA(0, 1, At, B1); PG8_BAR; PG8_SCHED;
            PG8_LDA(At, 0, 1); PG8_STAGE(PG8_SB(0, 0), b2, voffB); PG8_STAGE(PG8_SB(0, 1), b2 + hstep, voffB); PG8_STAGE(PG8_SA(0, 0), a2, voffA);
            PG8_WAIT_V(8); PG8_WAIT_L(0); PG8_BAR; PG8_MMA(1, 0, At, B0); PG8_MMA(1, 1, At, B1); PG8_BAR; PG8_SCHED;
            PG8_LDB(B0, 1, 0); PG8_LDB(B1, 1, 1); PG8_SCHED; PG8_LDA(At, 1, 0); PG8_STAGE(PG8_SA(0, 1), a2 + hstep, voffA);
            PG8_WAIT_V(8); PG8_WAIT_L(0); PG8_BAR; PG8_MMA(0, 0, At, B0); PG8_MMA(0, 1, At, B1); PG8_BAR; PG8_SCHED;
            PG8_LDA(At, 1, 1); PG8_STAGE(PG8_SB(1, 0), b3, voffB); PG8_STAGE(PG8_SB(1, 1), b3 + hstep, voffB); PG8_STAGE(PG8_SA(1, 0), a3, voffA);
            PG8_WAIT_V(8); PG8_WAIT_L(0); PG8_BAR; PG8_MMA(1, 0, At, B0); PG8_MMA(1, 1, At, B1); PG8_BAR; PG8_SCHED;
            } else {
            PG8_LDB(B0, 0, 0); PG8_SCHED; PG8_LDA(At, 0, 0); PG8_STAGE(PG8_SA(1, 1), a1 + hstep, voffA);
            PG8_WAIT_L(8); PG8_BAR; PG8_WAIT_L(0); PG8_MMA(0, 0, At, B0); PG8_BAR; PG8_SCHED;
            PG8_LDB(B1, 0, 1); PG8_STAGE(PG8_SB(0, 0), b2, voffB);
            PG8_BAR; PG8_WAIT_L(0); PG8_MMA(0, 1, At, B1); PG8_BAR;
            PG8_LDA(At, 0, 1); PG8_STAGE(PG8_SA(0, 0), a2, voffA);
            PG8_BAR; PG8_WAIT_L(0); PG8_MMA(1, 0, At, B0); PG8_BAR; PG8_SCHED;
            PG8_STAGE(PG8_SB(0, 1), b2 + hstep, voffB);
            PG8_WAIT_V(6); PG8_BAR; PG8_MMA(1, 1, At, B1); PG8_BAR;
            PG8_LDB(B0, 1, 0); PG8_SCHED; PG8_LDA(At, 1, 0); PG8_STAGE(PG8_SA(0, 1), a2 + hstep, voffA);
            PG8_WAIT_L(8); PG8_BAR; PG8_WAIT_L(0); PG8_MMA(0, 0, At, B0); PG8_BAR; PG8_SCHED;
            PG8_LDB(B1, 1, 1); PG8_STAGE(PG8_SB(1, 0), b3, voffB);
            PG8_BAR; PG8_WAIT_L(0); PG8_MMA(0, 1, At, B1); PG8_BAR;
            PG8_LDA(At, 1, 1); PG8_STAGE(PG8_SA(1, 0), a3, voffA);
            PG8_BAR; PG8_WAIT_L(0); PG8_MMA(1, 0, At, B0); PG8_BAR; PG8_SCHED;
            PG8_STAGE(PG8_SB(1, 1), b3 + hstep, voffB);
            PG8_WAIT_V(6); PG8_BAR; PG8_MMA(1, 1, At, B1); PG8_BAR;
            }
        }
        if constexpr (ALIGN_EPI) { if (wr == 0) PG8_BAR; }
        if constexpr (!Epi::AFTER_DRAIN) { E(acc, cur, wr, wc, fr, fq); S.done(cur); }
        if (!has_next) break;
#pragma unroll
        for (int a = 0; a < 2; ++a)
#pragma unroll
            for (int b = 0; b < 2; ++b)
#pragma unroll
                for (int m = 0; m < 4; ++m)
#pragma unroll
                    for (int n = 0; n < 2; ++n) acc[a][b][m][n] = (f32x4){0.f, 0.f, 0.f, 0.f};
        cur = nxt; cA = nA; cB = nB; ++ui;
        if constexpr (ALIGN_EPI) { if (wr == 1) PG8_BAR; }
    }
    PG8_WAIT_V(0);
    if constexpr (!ALIGN_EPI) { if (wr == 0) PG8_BAR; }
    PG8_BAR;
    if constexpr (Epi::AFTER_DRAIN) { E.fused(acc, cur, wr, wc, fr, fq, lds, wid, lane); S.done(cur); }
#undef PG8_SA
#undef PG8_SB
#undef PG8_STAGE
#undef PG8_LDA
#undef PG8_LDB
#undef PG8_MMA
#undef PG8_WAIT_V
#undef PG8_WAIT_L
#undef PG8_BAR
#undef PG8_SCHED
}
}

#ifndef PG8_SP2
#define PG8_SP2 true
#endif
#ifndef PG8_ALIGN
#define PG8_ALIGN true
#endif

constexpr int NWAVES = 8;
constexpr int BATCH = 4, SEQ = 4096, D = 1024, M = BATCH * SEQ, DEPTH = 4;
constexpr int NQKV = 3 * D, FF = 2816, FF2 = 2 * FF;
constexpr float LN_EPS = 1e-5f, RMS_EPS = 1e-5f;
constexpr float LOG2E = 1.4426950408889634f;
constexpr float QSCALE = 0.125f * LOG2E;
constexpr float ALPHA = 1.6817928305074290861f;
constexpr int PH_PER_LAYER = 9, N_PHASES = DEPTH * PH_PER_LAYER;
#ifndef MK_ONE_LAUNCH
#define MK_ONE_LAUNCH 0
#endif

constexpr size_t MiB = 1u << 20;
constexpr size_t WS_CTL = 0, CTL_ZERO_BYTES = 1 * MiB;
constexpr size_t WS_WQKV = 2 * MiB, WS_WO = 8 * MiB, WS_WIN = 10 * MiB, WS_WOUT = 21 * MiB;
constexpr size_t WS_XB = 28 * MiB;
constexpr size_t WS_ACT = 60 * MiB;
constexpr size_t WS_H = 148 * MiB;
constexpr size_t WS_Q = 148 * MiB, WS_K = 180 * MiB, WS_V = 212 * MiB, WS_O = 244 * MiB;
constexpr size_t WS_Y = 276 * MiB;
constexpr size_t WS_END = 340 * MiB;
constexpr int CW_BAR = 4096;

constexpr int RING_OFF = 0, RING_BYTES = 131072;
constexpr int LDSCTL_OFF = RING_BYTES, MISC_OFF = LDSCTL_OFF + 320;
constexpr int LDS_BYTES = 147456;

#define GAS __attribute__((address_space(1)))
#define LAS __attribute__((address_space(3)))
typedef unsigned short bf16;
typedef unsigned v4u __attribute__((ext_vector_type(4)));
typedef float f32x4 __attribute__((ext_vector_type(4)));
typedef short bf16x8 __attribute__((ext_vector_type(8)));
typedef GAS unsigned gu32;
typedef GAS unsigned long long gu64;
#define RLX_AGENT __ATOMIC_RELAXED, __HIP_MEMORY_SCOPE_AGENT
#define LDS_WAIT() asm volatile("s_waitcnt lgkmcnt(0)" ::: "memory")
#define VM_WAIT() asm volatile("s_waitcnt vmcnt(0)" ::: "memory")
__device__ __forceinline__ unsigned long long rt() { return __builtin_amdgcn_s_memrealtime(); }
__device__ __forceinline__ unsigned f2bf(float f) { unsigned u = __builtin_bit_cast(unsigned, f); return (u + 0x7fffu + ((u >> 16) & 1u)) >> 16; }
__device__ __forceinline__ unsigned pk2(float lo, float hi) { return f2bf(lo) | (f2bf(hi) << 16); }

#define XB_TMO      128
#define XB_XCNT(j)  (256  + 64 * (j))
#define XB_XSUB(j)  (1280 + 64 * (j))
#define XB_XGEN(j)  (2304 + 64 * (j))
#define XB_TOP      3328
#define XB_TOPGEN   3392
#define XCD_BAR_WORDS 3456
#define XB_SPIN_CAP (1u << 18)

__device__ __forceinline__ unsigned xb_ld(unsigned* p)              { return __hip_atomic_load(p, __ATOMIC_RELAXED, __HIP_MEMORY_SCOPE_AGENT); }
__device__ __forceinline__ unsigned xb_add(unsigned* p, unsigned v) { return __hip_atomic_fetch_add(p, v, __ATOMIC_RELAXED, __HIP_MEMORY_SCOPE_AGENT); }
__device__ __forceinline__ unsigned xb_xcc_id() { return (unsigned)__builtin_amdgcn_s_getreg((3 << 11) | 20) & 0xFu; }
#define XB_SPIN(cond, bar) do { unsigned _sp = 0; while (cond) { __builtin_amdgcn_s_sleep(1); \
    if ((++_sp & 255u) == 0u) { if (xb_ld(&(bar)[XB_TMO])) break; if (_sp > XB_SPIN_CAP) { atomicAdd(&(bar)[XB_TMO], 1u); break; } } } } while (0)

struct XcdBarrier {
    unsigned* bar; unsigned x;
    volatile LAS unsigned* st;
};

__device__ __forceinline__ XcdBarrier xcd_barrier_post(unsigned* bar, volatile LAS unsigned* st) {
    XcdBarrier b; b.bar = bar; b.x = xb_xcc_id(); b.st = st;
    if (threadIdx.x == 0) (void)xb_add(&bar[XB_XCNT(b.x)], 1u);
    return b;
}
__device__ __forceinline__ void xcd_barrier_complete(unsigned* bar, unsigned x, unsigned& nloc, unsigned& nx) {
    const unsigned G = gridDim.x * gridDim.y * gridDim.z;
    unsigned sum, cnt, mine, sp = 0u;
    for (;;) {
        sum = 0u; cnt = 0u; mine = 0u;
#pragma unroll
        for (unsigned j = 0; j < 16; ++j) { const unsigned c = xb_ld(&bar[XB_XCNT(j)]); sum += c; cnt += (c > 0u) ? 1u : 0u; mine = (j == x) ? c : mine; }
        if (sum == G) break;
        __builtin_amdgcn_s_sleep(1);
        if ((++sp & 255u) == 0u) { if (xb_ld(&bar[XB_TMO])) break; if (sp > XB_SPIN_CAP) { atomicAdd(&bar[XB_TMO], 1u); break; } }
    }
    nloc = mine > 0u ? mine : 1u; nx = cnt > 0u ? cnt : 1u;
}

__device__ __forceinline__ void xcd_barrier(const XcdBarrier& b) {
    asm volatile("s_waitcnt vmcnt(0)" ::: "memory");
    __syncthreads();
    if (threadIdx.x == 0) {
        unsigned* bar = b.bar;
        __builtin_amdgcn_s_waitcnt(0);
        unsigned nloc = b.st[0], nx = b.st[1];
        if (nloc == 0u) { xcd_barrier_complete(bar, b.x, nloc, nx); b.st[0] = nloc; b.st[1] = nx; }
        const unsigned old = xb_add(&bar[XB_XSUB(b.x)], 1u);
        const unsigned gen = old / nloc;
        if (old + 1u == (gen + 1u) * nloc) {
            __builtin_amdgcn_fence(__ATOMIC_RELEASE, "agent");
            asm volatile("s_waitcnt vmcnt(0)" ::: "memory");
            const unsigned og = xb_add(&bar[XB_TOP], 1u);
            const unsigned tg = og / nx;
            if (og + 1u == (tg + 1u) * nx) xb_add(&bar[XB_TOPGEN], 1u);
            else XB_SPIN(xb_ld(&bar[XB_TOPGEN]) == tg, bar);
            __builtin_amdgcn_fence(__ATOMIC_ACQUIRE, "agent");
            xb_add(&bar[XB_XGEN(b.x)], 1u);
            asm volatile("s_waitcnt vmcnt(0)" ::: "memory");
        } else {
            XB_SPIN(xb_ld(&bar[XB_XGEN(b.x)]) == gen, bar);
            __builtin_amdgcn_fence(__ATOMIC_ACQUIRE, "agent");
            asm volatile("s_waitcnt vmcnt(0)" ::: "memory");
        }
    }
    __syncthreads();
}


struct Args { const float* in[18]; float* out; unsigned char* ws; int ph_lo, ph_hi; };

struct Frame {
    LAS unsigned char* lds;
    volatile LAS unsigned* MISC;
    gu32* ctl;
    int tid, lane, wave, G, vcu;
};

__device__ __forceinline__ float wave_sum(float v) {
#pragma unroll
    for (int o = 1; o < 64; o <<= 1) v += __shfl_xor(v, o);
    return v;
}
__device__ __forceinline__ float wave_max(float v) {
#pragma unroll
    for (int o = 1; o < 64; o <<= 1) v = fmaxf(v, __shfl_xor(v, o));
    return v;
}
__device__ __forceinline__ float bf2f(unsigned short u) { return __builtin_bit_cast(float, (unsigned)u << 16); }

__device__ __forceinline__ void p0_transpose_item(const float* W, int K, int N, bf16* WT, int row_off, LAS float* scr, int item, int lane) {
    const int nblk = N / 32, kb = item / nblk, nb = item % nblk, k0 = 64 * kb, n0 = 32 * nb;
#pragma unroll 8
    for (int i = 0; i < 32; ++i) { const int kk = 2 * i + (lane >> 5); scr[kk * 33 + (lane & 31)] = W[(size_t)(k0 + kk) * N + n0 + (lane & 31)]; }
    LDS_WAIT(); asm volatile("" ::: "memory");
    const int c = lane & 7;
#pragma unroll
    for (int j = 0; j < 4; ++j) { const int n = (lane >> 3) + 8 * j; const LAS float* s = scr + (8 * c) * 33 + n;
        v4u o; o.x = pk2(s[0 * 33], s[1 * 33]); o.y = pk2(s[2 * 33], s[3 * 33]); o.z = pk2(s[4 * 33], s[5 * 33]); o.w = pk2(s[6 * 33], s[7 * 33]);
        *(GAS v4u*)(WT + (size_t)(row_off + n0 + n) * K + k0 + 8 * c) = o; }
    LDS_WAIT(); asm volatile("" ::: "memory");
}

__device__ __forceinline__ void ph_convert(const Args& a, Frame& F, int L) {
    LAS float* scr = (LAS float*)(F.lds + RING_OFF + F.wave * 16384);
    const int gw = F.vcu * NWAVES + F.wave, NGW = F.G * NWAVES;
    const int j = L >> 1;
    const float* wqkv = ((L & 1) ? a.in[5] : a.in[1]) + (size_t)j * D * NQKV;
    const float* wo = ((L & 1) ? a.in[8] : a.in[2]) + (size_t)j * D * D;
    const float* win = a.in[10] + (size_t)L * D * FF2;
    const float* wout = a.in[14] + (size_t)L * FF * D;
    bf16* WQKV = (bf16*)(a.ws + WS_WQKV); bf16* WO = (bf16*)(a.ws + WS_WO); bf16* WIN = (bf16*)(a.ws + WS_WIN); bf16* WOUT = (bf16*)(a.ws + WS_WOUT);
    constexpr int I_QKV = (D / 64) * (NQKV / 32), I_O = (D / 64) * (D / 32), I_IN = (D / 64) * (FF2 / 32), I_OUT = (FF / 64) * (D / 32);
    constexpr int NITEMS = I_QKV + I_O + I_IN + I_OUT;
    for (int it = gw; it < NITEMS; it += NGW) {
        int r = it;
        if (r < I_QKV) { p0_transpose_item(wqkv, D, NQKV, WQKV, 0, scr, r, F.lane); continue; } r -= I_QKV;
        if (r < I_O) { p0_transpose_item(wo, D, D, WO, 0, scr, r, F.lane); continue; } r -= I_O;
        if (r < I_IN) { p0_transpose_item(win, D, FF2, WIN, 0, scr, r, F.lane); continue; } r -= I_IN;
        p0_transpose_item(wout, FF, D, WOUT, 0, scr, r, F.lane);
    }
    if (L == 0) {
        bf16* XB = (bf16*)(a.ws + WS_XB);
        for (int m = gw; m < M; m += NGW) {
            const GAS f32x4* xr = (const GAS f32x4*)(a.in[0] + (size_t)m * D) + F.lane;
            GAS unsigned long long* o8 = (GAS unsigned long long*)(XB + (size_t)m * D) + F.lane;
#pragma unroll
            for (int q = 0; q < 4; ++q) { const f32x4 v = xr[64 * q]; o8[64 * q] = (unsigned long long)pk2(v.x, v.y) | ((unsigned long long)pk2(v.z, v.w) << 32); }
        }
    }
}

__device__ __forceinline__ void ph_ln(const Args& a, Frame& F, int L, int which) {
    const int gw = F.vcu * NWAVES + F.wave, NGW = F.G * NWAVES;
    const float* xin = (L == 0 && which == 0) ? a.in[0] : a.out;
    const float* Y = (const float*)(a.ws + WS_Y);
    const float* g = a.in[16] + (size_t)(L * 2 + which) * D; const float* bb = a.in[17] + (size_t)(L * 2 + which) * D;
    bf16* XB = (bf16*)(a.ws + WS_XB);
    f32x4 gv[4], bv[4];
#pragma unroll
    for (int q = 0; q < 4; ++q) { gv[q] = ((const GAS f32x4*)g)[F.lane + 64 * q]; bv[q] = ((const GAS f32x4*)bb)[F.lane + 64 * q]; }
    for (int m = gw; m < M; m += NGW) {
        const GAS f32x4* xr = (const GAS f32x4*)(xin + (size_t)m * D) + F.lane;
        const GAS f32x4* yr = (const GAS f32x4*)(Y + (size_t)m * D) + F.lane;
        f32x4 v[4]; float s = 0.f;
#pragma unroll
        for (int q = 0; q < 4; ++q) { v[q] = xr[64 * q] * ALPHA + yr[64 * q]; s += (v[q].x + v[q].y) + (v[q].z + v[q].w); }
        const float mean = wave_sum(s) * (1.f / D); float s2 = 0.f;
#pragma unroll
        for (int q = 0; q < 4; ++q) { v[q] = v[q] - mean; s2 += (v[q].x * v[q].x + v[q].y * v[q].y) + (v[q].z * v[q].z + v[q].w * v[q].w); }
        const float rstd = 1.f / sqrtf(wave_sum(s2) * (1.f / D) + LN_EPS);
        GAS f32x4* orow = (GAS f32x4*)(a.out + (size_t)m * D) + F.lane;
        GAS unsigned long long* o8 = (GAS unsigned long long*)(XB + (size_t)m * D) + F.lane;
#pragma unroll
        for (int q = 0; q < 4; ++q) { const f32x4 o = v[q] * rstd * gv[q] + bv[q]; orow[64 * q] = o;
            o8[64 * q] = (unsigned long long)pk2(o.x, o.y) | ((unsigned long long)pk2(o.z, o.w) << 32); }
    }
}

__device__ __forceinline__ void ph_conv(const Args& a, Frame& F, int L) {
    const bf16* H = (const bf16*)(a.ws + WS_H); bf16* ACT = (bf16*)(a.ws + WS_ACT);
    const float* cw = a.in[12] + (size_t)L * 3 * FF2; const float* cb = a.in[13] + (size_t)L * FF2;
    constexpr int CPR = FF / 8;
    const long total = (long)M * CPR, nthr = (long)F.G * NWAVES * 64;
    for (long idx = (long)F.vcu * NWAVES * 64 + F.tid; idx < total; idx += nthr) {
        const int row = (int)(idx / CPR), ch = (int)(idx % CPR), col = ch * 8, t = row % SEQ;
        float uo[8], go[8];
#pragma unroll
        for (int e = 0; e < 8; ++e) { uo[e] = cb[col + e]; go[e] = cb[FF + col + e]; }
#pragma unroll
        for (int k = 0; k < 3; ++k) {
            const int tt = t + k - 1; if (tt < 0 || tt >= SEQ) continue;
            const bf16* hp = H + (size_t)(row + k - 1) * FF2 + col;
            const bf16x8 hu = *(const bf16x8*)hp, hg = *(const bf16x8*)(hp + FF);
#pragma unroll
            for (int e = 0; e < 8; ++e) { uo[e] += cw[(size_t)k * FF2 + col + e] * bf2f((unsigned short)hu[e]); go[e] += cw[(size_t)k * FF2 + FF + col + e] * bf2f((unsigned short)hg[e]); }
        }
        v4u o; float r[8];
#pragma unroll
        for (int e = 0; e < 8; ++e) r[e] = uo[e] * (0.5f * go[e] * (1.0f + erff(go[e] * 0.70710678118654752f)));
        o.x = pk2(r[0], r[1]); o.y = pk2(r[2], r[3]); o.z = pk2(r[4], r[5]); o.w = pk2(r[6], r[7]);
        *(GAS v4u*)(ACT + (size_t)row * FF + col) = o;
    }
}

__device__ __forceinline__ void diff_scores(const bf16* kp, const LAS float* qs, float& s1, float& s2) {
    s1 = 0.f; s2 = 0.f;
    asm volatile("" ::: "memory");
#pragma unroll 4
    for (int c = 0; c < 16; ++c) {
        asm volatile("" ::: "memory");
        const bf16x8 kv = *(const bf16x8*)(kp + c * 8);
        const f32x4 q0 = *(const LAS f32x4*)(qs + c * 8), q1 = *(const LAS f32x4*)(qs + c * 8 + 4);
        float acc = q0.x * bf2f((unsigned short)kv[0]) + q0.y * bf2f((unsigned short)kv[1]) + q0.z * bf2f((unsigned short)kv[2]) + q0.w * bf2f((unsigned short)kv[3])
                  + q1.x * bf2f((unsigned short)kv[4]) + q1.y * bf2f((unsigned short)kv[5]) + q1.z * bf2f((unsigned short)kv[6]) + q1.w * bf2f((unsigned short)kv[7]);
        if (c < 8) s1 += acc; else s2 += acc;
    }
}
__device__ __forceinline__ void naive_diff_attn(const Args& a, Frame& F, int L) {
    const int gw = F.vcu * NWAVES + F.wave, NGW = F.G * NWAVES, lane = F.lane;
    const int j = L >> 1;
    const float lam_init = (L == 0) ? 0.2f : 0.47071301834358416f;
    const float* lf = a.in[3] + (size_t)j * 4 * 64;
    const float lam = expf(wave_sum(lf[lane] * lf[64 + lane])) - expf(wave_sum(lf[128 + lane] * lf[192 + lane])) + lam_init;
    const float* sg = a.in[4] + (size_t)j * 128;
    const float g0 = sg[lane], g1 = sg[64 + lane];
    const bf16* Q = (const bf16*)(a.ws + WS_Q); const bf16* K = (const bf16*)(a.ws + WS_K); const bf16* V = (const bf16*)(a.ws + WS_V); bf16* O = (bf16*)(a.ws + WS_O);
    LAS float* qs = (LAS float*)(F.lds + RING_OFF) + F.wave * 128;
    for (int task = gw; task < M * 8; task += NGW) {
        const int h = task & 7, row = task >> 3, b = row / SEQ, t = row % SEQ;
        const bf16* qp = Q + (size_t)row * D + h * 128;
        qs[lane] = bf2f(qp[lane]); qs[64 + lane] = bf2f(qp[64 + lane]);
        LDS_WAIT(); asm volatile("" ::: "memory");
        const float c2 = exp2f(-(float)(h + 1)) * LOG2E;
        const bf16* Kb = K + (size_t)b * SEQ * D + h * 128; const bf16* Vb = V + (size_t)b * SEQ * D + h * 128;
        float m1 = -1e30f, l1 = 0.f, m2 = -1e30f, l2 = 0.f;
        for (int tile = 0; tile < SEQ / 64; ++tile) {
            const int s = tile * 64 + lane; float s1, s2; diff_scores(Kb + (size_t)s * D, qs, s1, s2);
            const float pen = c2 * fabsf((float)(t - s)); s1 -= pen; s2 -= pen;
            float mn = fmaxf(m1, s1); l1 = l1 * exp2f(m1 - mn) + exp2f(s1 - mn); m1 = mn;
            mn = fmaxf(m2, s2); l2 = l2 * exp2f(m2 - mn) + exp2f(s2 - mn); m2 = mn;
        }
        const float M1 = wave_max(m1), M2 = wave_max(m2);
        const float i1 = 1.f / wave_sum(l1 * exp2f(m1 - M1)), i2 = lam / wave_sum(l2 * exp2f(m2 - M2));
        float o0 = 0.f, o1 = 0.f;
        for (int tile = 0; tile < SEQ / 64; ++tile) {
            const int s = tile * 64 + lane; float s1, s2; diff_scores(Kb + (size_t)s * D, qs, s1, s2);
            const float pen = c2 * fabsf((float)(t - s)); s1 -= pen; s2 -= pen;
            const float av = exp2f(s1 - M1) * i1 - exp2f(s2 - M2) * i2;
            const bf16* vp = Vb + (size_t)(tile * 64) * D + lane;
#pragma unroll 8
            for (int jj = 0; jj < 64; ++jj) { const float aj = __shfl(av, jj); o0 += aj * bf2f(vp[(size_t)jj * D]); o1 += aj * bf2f(vp[(size_t)jj * D + 64]); }
        }
        const float ms = wave_sum(o0 * o0 + o1 * o1) * (1.f / 128.f);
        const float r = (1.f / sqrtf(ms + RMS_EPS)) * (1.f - lam_init);
        bf16* op = O + (size_t)row * D + h * 128;
        op[lane] = (bf16)f2bf(o0 * r * g0); op[64 + lane] = (bf16)f2bf(o1 * r * g1);
        asm volatile("" ::: "memory");
    }
}

__device__ __forceinline__ void naive_na_attn(const Args& a, Frame& F, int L) {
    const int gw = F.vcu * NWAVES + F.wave, NGW = F.G * NWAVES, lane = F.lane;
    const int j = L >> 1;
    const float* rpb = a.in[7] + (size_t)j * 16 * 15 * 31;
    const bf16* Q = (const bf16*)(a.ws + WS_Q); const bf16* K = (const bf16*)(a.ws + WS_K); const bf16* V = (const bf16*)(a.ws + WS_V); bf16* O = (bf16*)(a.ws + WS_O);
    LAS float* qs = (LAS float*)(F.lds + RING_OFF) + F.wave * 128;
    for (int task = gw; task < M * 16; task += NGW) {
        const int h = task & 15, row = task >> 4, b = row / SEQ, t = row % SEQ, r = t >> 6, c = t & 63;
        const int rs = min(max(r - 4, 0), 56), cs = min(max(c - 8, 0), 48);
        qs[lane] = bf2f(Q[(size_t)row * D + h * 64 + lane]);
        LDS_WAIT(); asm volatile("" ::: "memory");
        const bf16* Kb = K + (size_t)b * SEQ * D + h * 64; const bf16* Vb = V + (size_t)b * SEQ * D + h * 64;
        float sc[2];
#pragma unroll
        for (int hf = 0; hf < 2; ++hf) {
            const int kk = lane + 64 * hf, i = kk >> 4, jj = kk & 15, kt = (rs + i) * 64 + cs + jj;
            const bf16* kp = Kb + (size_t)kt * D; float acc = 0.f;
#pragma unroll
            for (int cc = 0; cc < 8; ++cc) { const bf16x8 kv = *(const bf16x8*)(kp + cc * 8);
#pragma unroll
                for (int e = 0; e < 8; ++e) acc += qs[cc * 8 + e] * bf2f((unsigned short)kv[e]); }
            sc[hf] = acc + rpb[((size_t)h * 15 + (rs + i - r + 7)) * 31 + (cs + jj - c + 15)] * LOG2E;
        }
        const float mx = wave_max(fmaxf(sc[0], sc[1]));
        const float p0 = exp2f(sc[0] - mx), p1 = exp2f(sc[1] - mx);
        const float inv = 1.f / wave_sum(p0 + p1);
        float o = 0.f;
#pragma unroll 8
        for (int kk = 0; kk < 128; ++kk) { const int i = kk >> 4, jj = kk & 15, kt = (rs + i) * 64 + cs + jj;
            const float pk = __shfl(kk < 64 ? p0 : p1, kk & 63); o += pk * bf2f(Vb[(size_t)kt * D + lane]); }
        O[(size_t)row * D + h * 64 + lane] = (bf16)f2bf(o * inv);
        asm volatile("" ::: "memory");
    }
}

template <int S> __device__ __forceinline__ void run_phase(const Args& args, Frame& F, int L) {
    const int j = L >> 1; const bool na = (L & 1) != 0;
    bf16* WQKV = (bf16*)(args.ws + WS_WQKV); bf16* WO = (bf16*)(args.ws + WS_WO); bf16* WIN = (bf16*)(args.ws + WS_WIN); bf16* WOUT = (bf16*)(args.ws + WS_WOUT);
    bf16* XB = (bf16*)(args.ws + WS_XB); bf16* ACT = (bf16*)(args.ws + WS_ACT); bf16* HB = (bf16*)(args.ws + WS_H);
    bf16* QB = (bf16*)(args.ws + WS_Q); bf16* OB = (bf16*)(args.ws + WS_O); float* Y = (float*)(args.ws + WS_Y);
    if constexpr (S == 0) ph_convert(args, F, L);
    else if constexpr (S == 1) {
        pg8::Gemm g{XB, WQKV, M, NQKV, D}; pg8::StaticOrder So; So.init(M, NQKV, F.G, (int)blockIdx.x);
        pg8::EpiBf16<0> E{QB, D, na ? args.in[6] + (size_t)j * NQKV : nullptr, D, (size_t)(WS_K - WS_Q) / 2, QSCALE};
        pg8::gemm_phase<pg8::EpiBf16<0>, pg8::StaticOrder, PG8_ALIGN, PG8_SP2>(F.lds + RING_OFF, g, So, E);
    }
    else if constexpr (S == 2) { if (na) naive_na_attn(args, F, L); else naive_diff_attn(args, F, L); }
    else if constexpr (S == 3) {
        pg8::Gemm g{OB, WO, M, D, D}; pg8::StaticOrder So; So.init(M, D, F.G, (int)blockIdx.x);
        pg8::EpiF32 E{Y, D, na ? args.in[9] + (size_t)j * D : nullptr};
        pg8::gemm_phase<pg8::EpiF32, pg8::StaticOrder, PG8_ALIGN, PG8_SP2>(F.lds + RING_OFF, g, So, E);
    }
    else if constexpr (S == 4) ph_ln(args, F, L, 0);
    else if constexpr (S == 5) {
        pg8::Gemm g{XB, WIN, M, FF2, D}; pg8::StaticOrder So; So.init(M, FF2, F.G, (int)blockIdx.x);
        pg8::EpiBf16<0> E{HB, FF2, args.in[11] + (size_t)L * FF2, 0, 0, 1.f};
        pg8::gemm_phase<pg8::EpiBf16<0>, pg8::StaticOrder, PG8_ALIGN, PG8_SP2>(F.lds + RING_OFF, g, So, E);
    }
    else if constexpr (S == 6) ph_conv(args, F, L);
    else if constexpr (S == 7) {
        pg8::Gemm g{ACT, WOUT, M, D, FF}; pg8::StaticOrder So; So.init(M, D, F.G, (int)blockIdx.x);
        pg8::EpiF32 E{Y, D, args.in[15] + (size_t)L * D};
        pg8::gemm_phase<pg8::EpiF32, pg8::StaticOrder, PG8_ALIGN, PG8_SP2>(F.lds + RING_OFF, g, So, E);
    }
    else ph_ln(args, F, L, 1);
}
__device__ __forceinline__ void frame_init(Frame& F, const Args& args, unsigned char* lds) {
    F.lds = (LAS unsigned char*)lds;
    F.MISC = (volatile LAS unsigned*)(F.lds + MISC_OFF);
    F.tid = threadIdx.x; F.lane = F.tid & 63; F.wave = __builtin_amdgcn_readfirstlane(F.tid >> 6);
    F.G = gridDim.x; { const int bx = blockIdx.x; F.vcu = (F.G % 8 == 0) ? (bx % 8) * (F.G / 8) + bx / 8 : bx; }
    F.ctl = (gu32*)(args.ws + WS_CTL);
}
template <int S> __global__ void __launch_bounds__(NWAVES * 64, 2) phase_kernel(Args args) {
    extern __shared__ __attribute__((aligned(16))) unsigned char lds[];
    Frame F; frame_init(F, args, lds);
    run_phase<S>(args, F, args.ph_lo);
}

template <int S> static void launch_phase(int grid, Args a, int L, hipStream_t stream) {
    static bool attr = false;
    if (!attr) { (void)hipFuncSetAttribute((const void*)phase_kernel<S>, hipFuncAttributeMaxDynamicSharedMemorySize, LDS_BYTES); attr = true; }
    a.ph_lo = L; a.ph_hi = S;
    hipLaunchKernelGGL(phase_kernel<S>, dim3(grid), dim3(NWAVES * 64), LDS_BYTES, stream, a);
}
extern "C" void kernel_launch(void* const* d_in, const int* in_sizes, int n_in, void* d_out, int out_size, void* d_ws, size_t ws_size, hipStream_t stream) {
    static int grid = 0;
    if (grid == 0) {
        if (n_in != 18 || in_sizes[0] != M * D || out_size != M * D || ws_size < WS_END) { fprintf(stderr, "kernel_launch: unexpected shapes (n_in %d, in0 %d, out %d, ws %zu)\n", n_in, n_in > 0 ? in_sizes[0] : -1, out_size, ws_size); grid = -1; return; }
        int dev = 0, cus = 0;
        if (hipGetDevice(&dev) != hipSuccess || hipDeviceGetAttribute(&cus, hipDeviceAttributeMultiprocessorCount, dev) != hipSuccess) { grid = -1; return; }
        grid = cus;
    }
    if (grid < 0) return;
    (void)hipMemsetAsync((char*)d_ws + WS_CTL, 0, CTL_ZERO_BYTES, stream);
    Args a{};
    for (int i = 0; i < 18; ++i) a.in[i] = (const float*)d_in[i];
    a.out = (float*)d_out; a.ws = (unsigned char*)d_ws;
    for (int L = 0; L < DEPTH; ++L) {
        launch_phase<0>(grid, a, L, stream); launch_phase<1>(grid, a, L, stream); launch_phase<2>(grid, a, L, stream);
        launch_phase<3>(grid, a, L, stream); launch_phase<4>(grid, a, L, stream); launch_phase<5>(grid, a, L, stream);
        launch_phase<6>(grid, a, L, stream); launch_phase<7>(grid, a, L, stream); launch_phase<8>(grid, a, L, stream);
    }
}
```

```cpp
#include <hip/hip_runtime.h>
#include <cstdio>
#include <cstdint>
namespace pg8 {
#define PG8_LAS __attribute__((address_space(3)))
typedef unsigned short bf16_t;
typedef short bf16x8 __attribute__((ext_vector_type(8)));
typedef float f32x4 __attribute__((ext_vector_type(4)));
typedef unsigned u32x4 __attribute__((ext_vector_type(4)));
constexpr int BM = 256, BK = 64, HALF = 128, HTB = HALF * BK * 2  , STAGE_BYTES = 8 * HTB, NXCD = 8, WGM = 8;

__host__ __device__ __forceinline__ int lds_byte(int r, int c) { const int st = (r >> 4) * 2 + (c >> 5), rr = r & 15, cc = c & 31, ob = rr * 64 + cc * 2; return st * 1024 + (ob ^ (((ob >> 9) & 1) << 5)); }
__host__ __device__ __forceinline__ void stage_rc(int b, int& R, int& C) { const int st = b / 1024, sb = b % 1024, swz = sb ^ (((sb >> 9) & 1) << 5); R = (st >> 1) * 16 + swz / 64; C = (st & 1) * 32 + (swz % 64) / 2; }
__host__ __device__ __forceinline__ int perm32(int rho) { const int n = rho >> 4, i = rho & 15; return 8 * (i >> 2) + 4 * n + (i & 3); }

struct Unit { int pm, pn; };
struct Gemm { const bf16_t* A; const bf16_t* Bt; int M, N, K; };

struct StaticOrder {
    int nM, nN, nwg, G, c;
    __host__ __device__ void init(int M, int N, int G_, int c_) { nM = M / BM; nN = N / BM; nwg = nM * nN; G = G_; c = c_; }
    __host__ __device__ bool next(int i, Unit& u) const {
        const long L = (long)i * G + c; if (L >= nwg) return false;
        int wgid = (int)L; { const int q = nwg / NXCD, r = nwg % NXCD, xcd = wgid % NXCD, off = wgid / NXCD; wgid = (xcd < r ? xcd * (q + 1) : r * (q + 1) + (xcd - r) * q) + off; }
        const int nig = WGM * nN, gid = wgid / nig, fm = gid * WGM, gsz = (nM - fm) < WGM ? (nM - fm) : WGM;
        u.pm = fm + ((wgid % nig) % gsz); u.pn = (wgid % nig) / gsz; return true;
    }
    __device__ __forceinline__ void a_ready(const Unit&) const {}
    __device__ __forceinline__ void done(const Unit&) const {}
};

__device__ __forceinline__ unsigned cvt_pk_bf16(float lo, float hi) { unsigned r; asm volatile("v_cvt_pk_bf16_f32 %0, %1, %2" : "=v"(r) : "v"(lo), "v"(hi)); return r; }
typedef float f32x2 __attribute__((ext_vector_type(2)));
__device__ __forceinline__ f32x2 gelu_pk(f32x2 v) {
    const f32x2 av = __builtin_elementwise_abs(v), d = av * 0.2316418882f + 1.0f;
    f32x2 t; t.x = __builtin_amdgcn_rcpf(d.x); t.y = __builtin_amdgcn_rcpf(d.y);
    f32x2 q = t * 0.5307027145f + (-0.7265760135f); q = q * t + 0.7107068705f; q = q * t + (-0.142248368f); q = q * t + 0.127414796f; q = q * t;
    const f32x2 s = (v * v) * (-0.72134752044f);
    f32x2 e; e.x = __builtin_amdgcn_exp2f(s.x); e.y = __builtin_amdgcn_exp2f(s.y);
    const f32x2 m = v * (q * e), r = v - m;
    f32x2 o; o.x = v.x < 0.f ? m.x : r.x; o.y = v.y < 0.f ? m.y : r.y; return o;
}

template <int ACT  > struct EpiBf16 {
    static constexpr bool PERM = true, AFTER_DRAIN = false; static_assert(ACT == 0 || ACT == 1, "EpiBf16: ACT is 0 (none) or 1 (gelu_pk)");
    bf16_t* O; int ldc; const float* bias; int split_cols; size_t split_stride; float scale0;
    __device__ __forceinline__ void operator()(const f32x4 (&acc)[2][2][4][2], const Unit& u, int wr, int wc, int fr, int fq) const {
        const int row0 = u.pm * BM + wr * 64 + fr; int colt = u.pn * BM; bf16_t* base = O;
        float sc = 1.f; if (split_cols) { const int t = colt / split_cols; base += (size_t)t * split_stride; colt -= t * split_cols; if (t == 0) sc = scale0; }
        const int col0 = colt + wc * 32 + 8 * fq, bcol0 = u.pn * BM + wc * 32 + 8 * fq;
        f32x4 bv[2][2];
#pragma unroll
        for (int bj = 0; bj < 2; ++bj)
#pragma unroll
            for (int n = 0; n < 2; ++n) bv[bj][n] = bias ? *(const f32x4*)(bias + bcol0 + bj * HALF + 4 * n) : (f32x4){0.f, 0.f, 0.f, 0.f};
#pragma unroll
        for (int ai = 0; ai < 2; ++ai)
#pragma unroll
            for (int m = 0; m < 4; ++m) { bf16_t* rowp = base + (size_t)(row0 + ai * HALF + m * 16) * ldc + col0;
#pragma unroll
                for (int bj = 0; bj < 2; ++bj) { f32x4 v0 = acc[ai][bj][m][0] + bv[bj][0], v1 = acc[ai][bj][m][1] + bv[bj][1];
                    if (ACT == 1) { f32x2 a = gelu_pk((f32x2){v0[0], v0[1]}), b = gelu_pk((f32x2){v0[2], v0[3]}), c = gelu_pk((f32x2){v1[0], v1[1]}), d = gelu_pk((f32x2){v1[2], v1[3]});
                        v0 = (f32x4){a.x, a.y, b.x, b.y}; v1 = (f32x4){c.x, c.y, d.x, d.y}; }
                    v0 = v0 * sc; v1 = v1 * sc; u32x4 w; w.x = cvt_pk_bf16(v0[0], v0[1]); w.y = cvt_pk_bf16(v0[2], v0[3]); w.z = cvt_pk_bf16(v1[0], v1[1]); w.w = cvt_pk_bf16(v1[2], v1[3]);
                    *(u32x4*)(rowp + bj * HALF) = w; } }
    }
};
struct EpiF32 {
    static constexpr bool PERM = false, AFTER_DRAIN = false;
    float* C; int ldc; const float* bias;
    __device__ __forceinline__ void operator()(const f32x4 (&acc)[2][2][4][2], const Unit& u, int wr, int wc, int fr, int fq) const {
        const int row0 = u.pm * BM + wr * 64 + fr, col0 = u.pn * BM + wc * 32 + 4 * fq;
        f32x4 bv[2][2];
#pragma unroll
        for (int bj = 0; bj < 2; ++bj)
#pragma unroll
            for (int n = 0; n < 2; ++n) bv[bj][n] = bias ? *(const f32x4*)(bias + col0 + bj * HALF + n * 16) : (f32x4){0.f, 0.f, 0.f, 0.f};
#pragma unroll
        for (int ai = 0; ai < 2; ++ai)
#pragma unroll
            for (int m = 0; m < 4; ++m) { float* rowp = C + (size_t)(row0 + ai * HALF + m * 16) * ldc + col0;
#pragma unroll
                for (int bj = 0; bj < 2; ++bj)
#pragma unroll
                    for (int n = 0; n < 2; ++n) *(f32x4*)(rowp + bj * HALF + n * 16) = acc[ai][bj][m][n] + bv[bj][n]; }
    }
};
template <class Epi, class Sched, bool ALIGN_EPI = false, bool SP2 = false>
__device__ __forceinline__ void gemm_phase(PG8_LAS unsigned char* lds, const Gemm g, const Sched& S, const Epi& E) {
    int tid_ = threadIdx.x; asm volatile("" : "+v"(tid_));
    const int tid = tid_, wid = __builtin_amdgcn_readfirstlane(tid >> 6), lane = tid & 63, wr = wid >> 2, wc = wid & 3, fr = lane & 15, fq = lane >> 4;
    const int K = g.K, nt = K / BK;
    unsigned voffA[2], voffB[2];
#pragma unroll
    for (int i = 0; i < 2; ++i) { int R, C; stage_rc(tid * 16 + i * 8192, R, C); const int Rb = Epi::PERM ? ((R & ~31) + perm32(R & 31)) : R;
        voffA[i] = (unsigned)(R * K + C) * 2u; voffB[i] = (unsigned)(Rb * K + C) * 2u; }
    const size_t kstep = (size_t)(BK * 2);
    const size_t hstep = (size_t)HALF * K * 2;
    const size_t tstep = 2 * hstep;
    const unsigned ldsw = (unsigned)wid * 1024u;
    const int aoff = lds_byte(wr * 64 + fr, fq * 8), boff = lds_byte(wc * 32 + fr, fq * 8);
#define PG8_SA(b, h) (((b) * 2 + (h)) * HTB)
#define PG8_SB(b, h) ((4 + (b) * 2 + (h)) * HTB)
#define PG8_STAGE(bufoff, gbase, voff) do { _Pragma("unroll") for (int _i = 0; _i < 2; ++_i) \
        __builtin_amdgcn_global_load_lds((const unsigned*)((const char*)(gbase) + (voff)[_i]), (PG8_LAS unsigned*)(lds + (bufoff) + ldsw + _i * 8192), 16, 0, 0); } while (0)
#define PG8_LDA(dst, b, h) do { _Pragma("unroll") for (int m = 0; m < 4; ++m) _Pragma("unroll") for (int k = 0; k < 2; ++k) dst[m][k] = *(const PG8_LAS bf16x8*)(lds + PG8_SA(b, h) + aoff + m * 2048 + k * 1024); } while (0)
#define PG8_LDB(dst, b, h) do { _Pragma("unroll") for (int n = 0; n < 2; ++n) _Pragma("unroll") for (int k = 0; k < 2; ++k) dst[n][k] = *(const PG8_LAS bf16x8*)(lds + PG8_SB(b, h) + boff + n * 2048 + k * 1024); } while (0)
#define PG8_MMA(ai, bj, At, Bt) do { __builtin_amdgcn_s_setprio(1); _Pragma("unroll") for (int m = 0; m < 4; ++m) _Pragma("unroll") for (int n = 0; n < 2; ++n) _Pragma("unroll") for (int k = 0; k < 2; ++k) \
        acc[ai][bj][m][n] = __builtin_amdgcn_mfma_f32_16x16x32_bf16(Bt[n][k], At[m][k], acc[ai][bj][m][n], 0, 0, 0); __builtin_amdgcn_s_setprio(0); } while (0)
#define PG8_WAIT_V(n) asm volatile("s_waitcnt vmcnt(" #n ")" ::: "memory")
#define PG8_WAIT_L(n) asm volatile("s_waitcnt lgkmcnt(" #n ")" ::: "memory")
#define PG8_BAR __builtin_amdgcn_s_barrier()
#define PG8_SCHED __builtin_amdgcn_sched_barrier(0)
    Unit cur, nxt; int ui = 0;
    if (!S.next(0, cur)) return;
    f32x4 acc[2][2][4][2];
#pragma unroll
    for (int a = 0; a < 2; ++a)
#pragma unroll
        for (int b = 0; b < 2; ++b)
#pragma unroll
            for (int m = 0; m < 4; ++m)
#pragma unroll
                for (int n = 0; n < 2; ++n) acc[a][b][m][n] = (f32x4){0.f, 0.f, 0.f, 0.f};
    bf16x8 At[4][2], B0[2][2], B1[2][2];
    const char* cA = (const char*)g.A + (size_t)cur.pm * tstep; const char* cB = (const char*)g.Bt + (size_t)cur.pn * tstep;
    S.a_ready(cur);
    if constexpr (SP2) {
        PG8_STAGE(PG8_SB(0, 0), cB, voffB); PG8_STAGE(PG8_SB(0, 1), cB + hstep, voffB); PG8_STAGE(PG8_SA(0, 0), cA, voffA); PG8_STAGE(PG8_SA(0, 1), cA + hstep, voffA);
        if (wr == 1) PG8_BAR;
        PG8_WAIT_V(2); PG8_BAR;
        PG8_STAGE(PG8_SB(1, 0), cB + kstep, voffB); PG8_STAGE(PG8_SA(1, 0), cA + kstep, voffA); PG8_STAGE(PG8_SB(1, 1), cB + hstep + kstep, voffB);
        PG8_WAIT_V(6); PG8_BAR;
    } else {
        PG8_STAGE(PG8_SB(0, 0), cB, voffB); PG8_STAGE(PG8_SA(0, 0), cA, voffA); PG8_STAGE(PG8_SB(0, 1), cB + hstep, voffB); PG8_STAGE(PG8_SA(0, 1), cA + hstep, voffA);
        if (wr == 1) PG8_BAR;
        PG8_WAIT_V(4); PG8_BAR;
        PG8_STAGE(PG8_SB(1, 0), cB + kstep, voffB); PG8_STAGE(PG8_SA(1, 0), cA + kstep, voffA); PG8_STAGE(PG8_SB(1, 1), cB + hstep + kstep, voffB);
        PG8_WAIT_V(6); PG8_BAR;
    }
    for (;;) {
        const bool has_next = S.next(ui + 1, nxt);
        const char* nA = has_next ? (const char*)g.A + (size_t)nxt.pm * tstep : cA; const char* nB = has_next ? (const char*)g.Bt + (size_t)nxt.pn * tstep : cB;
        for (int t = 0; t < nt; t += 2) {
            const bool last = (t == nt - 2);
            const char* a1 = cA + (size_t)(t + 1) * kstep;
            const char* a2 = last ? nA : cA + (size_t)(t + 2) * kstep; const char* b2 = last ? nB : cB + (size_t)(t + 2) * kstep;
            const char* a3 = a2 + kstep; const char* b3 = b2 + kstep;
            if (last && has_next) S.a_ready(nxt);
            if constexpr (SP2) {
            PG8_LDB(B0, 0, 0); PG8_LDB(B1, 0, 1); PG8_SCHED; PG8_LDA(At, 0, 0); PG8_STAGE(PG8_SA(1, 1), a1 + hstep, voffA);
            PG8_WAIT_V(8); PG8_WAIT_L(0); PG8_BAR; PG8_MMA(0, 0, At, B0); PG8_MMA(0, 1, At, B1); PG8_BAR; PG8_SCHED;
            PG8_LDA(At, 0, 1); PG8_STAGE(PG8_SB(0, 0), b2, voffB); PG8_STAGE(PG8_SB(0, 1), b2 + hstep, voffB); PG8_STAGE(PG8_SA(0, 0), a2, voffA);
            PG8_WAIT_V(8); PG8_WAIT_L(0); PG8_BAR; PG8_MMA(1, 0, At, B0); PG8_MMA(1, 1, At, B1); PG8_BAR; PG8_SCHED;
            PG8_LDB(B0, 1, 0); PG8_LDB(B1, 1, 1); PG8_SCHED; PG8_LDA(At, 1, 0); PG8_STAGE(PG8_SA(0, 1), a2 + hstep, voffA);
            PG8_WAIT_V(8); PG8_WAIT_L(0); PG8_BAR; PG8_MMA(0, 0, At, B0); PG8_MMA(0, 1, At, B1); PG8_BAR; PG8_SCHED;
            PG8_LDA(At, 1, 1); PG8_STAGE(PG8_SB(1, 0), b3, voffB); PG8_STAGE(PG8_SB(1, 1), b3 + hstep, voffB); PG8_STAGE(PG8_SA(1, 0), a3, voffA);
            PG8_WAIT_V(8); PG8_WAIT_L(0); PG8_BAR; PG8_MMA(1, 0, At, B0); PG8_MMA(1, 1, At, B1); PG8_BAR; PG8_SCHED;
            } else {
            PG8_LDB(B0, 0, 0); PG8_SCHED; PG8_LDA(At, 0, 0); PG8_STAGE(PG8_SA(1, 1), a1 + hstep, voffA);
            PG8_WAIT_L(8); PG8_BAR; PG8_WAIT_L(0); PG8_MMA(0, 0, At, B0); PG8_BAR; PG8_SCHED;
            PG8_LDB(B1, 0, 1); PG8_STAGE(PG8_SB(0, 0), b2, voffB);
            PG8_BAR; PG8_WAIT_L(0); PG8_MMA(0, 1, At, B1); PG8_BAR;
            PG8_LDA(At, 0, 1); PG8_STAGE(PG8_SA(0, 0), a2, voffA);
            PG8_BAR; PG8_WAIT_L(0); PG8_MMA(1, 0, At, B0); PG8_BAR; PG8_SCHED;
            PG8_STAGE(PG8_SB(0, 1), b2 + hstep, voffB);
            PG8_WAIT_V(6); PG8_BAR; PG8_MMA(1, 1, At, B1); PG8_BAR;
            PG8_LDB(B0, 1, 0); PG8_SCHED; PG8_LDA(At, 1, 0); PG8_STAGE(PG8_SA(0, 1), a2 + hstep, voffA);
            PG8_WAIT_L(8); PG8_BAR; PG8_WAIT_L(0); PG8_MMA(0, 0, At, B0); PG8_BAR; PG8_SCHED;
            PG8_LDB(B1, 1, 1); PG8_STAGE(PG8_SB(1, 0), b3, voffB);
            PG8_BAR; PG8_WAIT_L(0); PG8_MMA(0, 1, At, B1); PG8_BAR;
            PG8_LDA(At, 1, 1); PG8_STAGE(PG8_SA(1, 0), a3, voffA);
            PG8_BAR; PG8_WAIT_L(0); PG8_MMA(1, 0, At, B0); PG8_BAR; PG8_SCHED;
            PG8_STAGE(PG8_SB(1, 1), b3 + hstep, voffB);
            PG8_WAIT_V(6); PG8_BAR; PG8_MMA(1, 1, At, B1); PG8_BAR;
            }
        }
        if constexpr (ALIGN_EPI) { if (wr == 0) PG8_BAR; }
        if constexpr (!Epi::AFTER_DRAIN) { E(acc, cur, wr, wc, fr, fq); S.done(cur); }
        if (!has_next) break;
#pragma unroll
        for (int a = 0; a < 2; ++a)
#pragma unroll
            for (int b = 0; b < 2; ++b)
#pragma unroll
                for (int m = 0; m < 4; ++m)
#pragma unroll
                    for (int n = 0; n < 2; ++n) acc[a][b][m][n] = (f32x4){0.f, 0.f, 0.f, 0.f};
        cur = nxt; cA = nA; cB = nB; ++ui;
        if constexpr (ALIGN_EPI) { if (wr == 1) PG8_BAR; }
    }
    PG8_WAIT_V(0);
    if constexpr (!ALIGN_EPI) { if (wr == 0) PG8_BAR; }
    PG8_BAR;
    if constexpr (Epi::AFTER_DRAIN) { E.fused(acc, cur, wr, wc, fr, fq, lds, wid, lane); S.done(cur); }
#undef PG8_SA
#undef PG8_SB
#undef PG8_STAGE
#undef PG8_LDA
#undef PG8_LDB
#undef PG8_MMA
#undef PG8_WAIT_V
#undef PG8_WAIT_L
#undef PG8_BAR
#undef PG8_SCHED
}
}

#ifndef PG8_SP2
#define PG8_SP2 true
#endif
#ifndef PG8_ALIGN
#define PG8_ALIGN true
#endif

constexpr int NWAVES = 8;
constexpr int BATCH = 4, SEQ = 4096, D = 1024, M = BATCH * SEQ, DEPTH = 4;
constexpr int NQKV = 3 * D, FF = 2816, FF2 = 2 * FF;
constexpr float LN_EPS = 1e-5f, RMS_EPS = 1e-5f;
constexpr float LOG2E = 1.4426950408889634f;
constexpr float QSCALE = 0.125f * LOG2E;
constexpr float ALPHA = 1.6817928305074290861f;
constexpr int PH_PER_LAYER = 9, N_PHASES = DEPTH * PH_PER_LAYER;
#ifndef MK_ONE_LAUNCH
#define MK_ONE_LAUNCH 1
#endif

constexpr size_t MiB = 1u << 20;
constexpr size_t WS_CTL = 0, CTL_ZERO_BYTES = 1 * MiB;
constexpr size_t WS_WQKV = 2 * MiB, WS_WO = 8 * MiB, WS_WIN = 10 * MiB, WS_WOUT = 21 * MiB;
constexpr size_t WS_XB = 28 * MiB;
constexpr size_t WS_ACT = 60 * MiB;
constexpr size_t WS_H = 148 * MiB;
constexpr size_t WS_Q = 148 * MiB, WS_K = 180 * MiB, WS_V = 212 * MiB, WS_O = 244 * MiB;
constexpr size_t WS_Y = 276 * MiB;
constexpr size_t WS_END = 340 * MiB;
constexpr int CW_BAR = 4096;

constexpr int RING_OFF = 0, RING_BYTES = 131072;
constexpr int LDSCTL_OFF = RING_BYTES, MISC_OFF = LDSCTL_OFF + 320;
constexpr int LDS_BYTES = 147456;

#define GAS __attribute__((address_space(1)))
#define LAS __attribute__((address_space(3)))
typedef unsigned short bf16;
typedef unsigned v4u __attribute__((ext_vector_type(4)));
typedef float f32x4 __attribute__((ext_vector_type(4)));
typedef short bf16x8 __attribute__((ext_vector_type(8)));
typedef GAS unsigned gu32;
typedef GAS unsigned long long gu64;
#define RLX_AGENT __ATOMIC_RELAXED, __HIP_MEMORY_SCOPE_AGENT
#define LDS_WAIT() asm volatile("s_waitcnt lgkmcnt(0)" ::: "memory")
#define VM_WAIT() asm volatile("s_waitcnt vmcnt(0)" ::: "memory")
__device__ __forceinline__ unsigned long long rt() { return __builtin_amdgcn_s_memrealtime(); }
__device__ __forceinline__ unsigned f2bf(float f) { unsigned u = __builtin_bit_cast(unsigned, f); return (u + 0x7fffu + ((u >> 16) & 1u)) >> 16; }
__device__ __forceinline__ unsigned pk2(float lo, float hi) { return f2bf(lo) | (f2bf(hi) << 16); }

#define XB_TMO      128
#define XB_XCNT(j)  (256  + 64 * (j))
#define XB_XSUB(j)  (1280 + 64 * (j))
#define XB_XGEN(j)  (2304 + 64 * (j))
#define XB_TOP      3328
#define XB_TOPGEN   3392
#define XCD_BAR_WORDS 3456
#define XB_SPIN_CAP (1u << 18)

__device__ __forceinline__ unsigned xb_ld(unsigned* p)              { return __hip_atomic_load(p, __ATOMIC_RELAXED, __HIP_MEMORY_SCOPE_AGENT); }
__device__ __forceinline__ unsigned xb_add(unsigned* p, unsigned v) { return __hip_atomic_fetch_add(p, v, __ATOMIC_RELAXED, __HIP_MEMORY_SCOPE_AGENT); }
__device__ __forceinline__ unsigned xb_xcc_id() { return (unsigned)__builtin_amdgcn_s_getreg((3 << 11) | 20) & 0xFu; }
#define XB_SPIN(cond, bar) do { unsigned _sp = 0; while (cond) { __builtin_amdgcn_s_sleep(1); \
    if ((++_sp & 255u) == 0u) { if (xb_ld(&(bar)[XB_TMO])) break; if (_sp > XB_SPIN_CAP) { atomicAdd(&(bar)[XB_TMO], 1u); break; } } } } while (0)

struct XcdBarrier {
    unsigned* bar; unsigned x;
    volatile LAS unsigned* st;
};

__device__ __forceinline__ XcdBarrier xcd_barrier_post(unsigned* bar, volatile LAS unsigned* st) {
    XcdBarrier b; b.bar = bar; b.x = xb_xcc_id(); b.st = st;
    if (threadIdx.x == 0) (void)xb_add(&bar[XB_XCNT(b.x)], 1u);
    return b;
}
__device__ __forceinline__ void xcd_barrier_complete(unsigned* bar, unsigned x, unsigned& nloc, unsigned& nx) {
    const unsigned G = gridDim.x * gridDim.y * gridDim.z;
    unsigned sum, cnt, mine, sp = 0u;
    for (;;) {
        sum = 0u; cnt = 0u; mine = 0u;
#pragma unroll
        for (unsigned j = 0; j < 16; ++j) { const unsigned c = xb_ld(&bar[XB_XCNT(j)]); sum += c; cnt += (c > 0u) ? 1u : 0u; mine = (j == x) ? c : mine; }
        if (sum == G) break;
        __builtin_amdgcn_s_sleep(1);
        if ((++sp & 255u) == 0u) { if (xb_ld(&bar[XB_TMO])) break; if (sp > XB_SPIN_CAP) { atomicAdd(&bar[XB_TMO], 1u); break; } }
    }
    nloc = mine > 0u ? mine : 1u; nx = cnt > 0u ? cnt : 1u;
}

__device__ __forceinline__ void xcd_barrier(const XcdBarrier& b) {
    asm volatile("s_waitcnt vmcnt(0)" ::: "memory");
    __syncthreads();
    if (threadIdx.x == 0) {
        unsigned* bar = b.bar;
        __builtin_amdgcn_s_waitcnt(0);
        unsigned nloc = b.st[0], nx = b.st[1];
        if (nloc == 0u) { xcd_barrier_complete(bar, b.x, nloc, nx); b.st[0] = nloc; b.st[1] = nx; }
        const unsigned old = xb_add(&bar[XB_XSUB(b.x)], 1u);
        const unsigned gen = old / nloc;
        if (old + 1u == (gen + 1u) * nloc) {
            __builtin_amdgcn_fence(__ATOMIC_RELEASE, "agent");
            asm volatile("s_waitcnt vmcnt(0)" ::: "memory");
            const unsigned og = xb_add(&bar[XB_TOP], 1u);
            const unsigned tg = og / nx;
            if (og + 1u == (tg + 1u) * nx) xb_add(&bar[XB_TOPGEN], 1u);
            else XB_SPIN(xb_ld(&bar[XB_TOPGEN]) == tg, bar);
            __builtin_amdgcn_fence(__ATOMIC_ACQUIRE, "agent");
            xb_add(&bar[XB_XGEN(b.x)], 1u);
            asm volatile("s_waitcnt vmcnt(0)" ::: "memory");
        } else {
            XB_SPIN(xb_ld(&bar[XB_XGEN(b.x)]) == gen, bar);
            __builtin_amdgcn_fence(__ATOMIC_ACQUIRE, "agent");
            asm volatile("s_waitcnt vmcnt(0)" ::: "memory");
        }
    }
    __syncthreads();
}


struct Args { const float* in[18]; float* out; unsigned char* ws; int ph_lo, ph_hi; };

struct Frame {
    LAS unsigned char* lds;
    volatile LAS unsigned* MISC;
    gu32* ctl;
    int tid, lane, wave, G, vcu;
};

__device__ __forceinline__ float wave_sum(float v) {
#pragma unroll
    for (int o = 1; o < 64; o <<= 1) v += __shfl_xor(v, o);
    return v;
}
__device__ __forceinline__ float wave_max(float v) {
#pragma unroll
    for (int o = 1; o < 64; o <<= 1) v = fmaxf(v, __shfl_xor(v, o));
    return v;
}
__device__ __forceinline__ float bf2f(unsigned short u) { return __builtin_bit_cast(float, (unsigned)u << 16); }

__device__ __forceinline__ void p0_transpose_item(const float* W, int K, int N, bf16* WT, int row_off, LAS float* scr, int item, int lane) {
    const int nblk = N / 32, kb = item / nblk, nb = item % nblk, k0 = 64 * kb, n0 = 32 * nb;
#pragma unroll 8
    for (int i = 0; i < 32; ++i) { const int kk = 2 * i + (lane >> 5); scr[kk * 33 + (lane & 31)] = W[(size_t)(k0 + kk) * N + n0 + (lane & 31)]; }
    LDS_WAIT(); asm volatile("" ::: "memory");
    const int c = lane & 7;
#pragma unroll
    for (int j = 0; j < 4; ++j) { const int n = (lane >> 3) + 8 * j; const LAS float* s = scr + (8 * c) * 33 + n;
        v4u o; o.x = pk2(s[0 * 33], s[1 * 33]); o.y = pk2(s[2 * 33], s[3 * 33]); o.z = pk2(s[4 * 33], s[5 * 33]); o.w = pk2(s[6 * 33], s[7 * 33]);
        *(GAS v4u*)(WT + (size_t)(row_off + n0 + n) * K + k0 + 8 * c) = o; }
    LDS_WAIT(); asm volatile("" ::: "memory");
}

__device__ __forceinline__ void ph_convert(const Args& a, Frame& F, int L) {
    LAS float* scr = (LAS float*)(F.lds + RING_OFF + F.wave * 16384);
    const int gw = F.vcu * NWAVES + F.wave, NGW = F.G * NWAVES;
    const int j = L >> 1;
    const float* wqkv = ((L & 1) ? a.in[5] : a.in[1]) + (size_t)j * D * NQKV;
    const float* wo = ((L & 1) ? a.in[8] : a.in[2]) + (size_t)j * D * D;
    const float* win = a.in[10] + (size_t)L * D * FF2;
    const float* wout = a.in[14] + (size_t)L * FF * D;
    bf16* WQKV = (bf16*)(a.ws + WS_WQKV); bf16* WO = (bf16*)(a.ws + WS_WO); bf16* WIN = (bf16*)(a.ws + WS_WIN); bf16* WOUT = (bf16*)(a.ws + WS_WOUT);
    constexpr int I_QKV = (D / 64) * (NQKV / 32), I_O = (D / 64) * (D / 32), I_IN = (D / 64) * (FF2 / 32), I_OUT = (FF / 64) * (D / 32);
    constexpr int NITEMS = I_QKV + I_O + I_IN + I_OUT;
    for (int it = gw; it < NITEMS; it += NGW) {
        int r = it;
        if (r < I_QKV) { p0_transpose_item(wqkv, D, NQKV, WQKV, 0, scr, r, F.lane); continue; } r -= I_QKV;
        if (r < I_O) { p0_transpose_item(wo, D, D, WO, 0, scr, r, F.lane); continue; } r -= I_O;
        if (r < I_IN) { p0_transpose_item(win, D, FF2, WIN, 0, scr, r, F.lane); continue; } r -= I_IN;
        p0_transpose_item(wout, FF, D, WOUT, 0, scr, r, F.lane);
    }
    if (L == 0) {
        bf16* XB = (bf16*)(a.ws + WS_XB);
        for (int m = gw; m < M; m += NGW) {
            const GAS f32x4* xr = (const GAS f32x4*)(a.in[0] + (size_t)m * D) + F.lane;
            GAS unsigned long long* o8 = (GAS unsigned long long*)(XB + (size_t)m * D) + F.lane;
#pragma unroll
            for (int q = 0; q < 4; ++q) { const f32x4 v = xr[64 * q]; o8[64 * q] = (unsigned long long)pk2(v.x, v.y) | ((unsigned long long)pk2(v.z, v.w) << 32); }
        }
    }
}

__device__ __forceinline__ void ph_ln(const Args& a, Frame& F, int L, int which) {
    const int gw = F.vcu * NWAVES + F.wave, NGW = F.G * NWAVES;
    const float* xin = (L == 0 && which == 0) ? a.in[0] : a.out;
    const float* Y = (const float*)(a.ws + WS_Y);
    const float* g = a.in[16] + (size_t)(L * 2 + which) * D; const float* bb = a.in[17] + (size_t)(L * 2 + which) * D;
    bf16* XB = (bf16*)(a.ws + WS_XB);
    f32x4 gv[4], bv[4];
#pragma unroll
    for (int q = 0; q < 4; ++q) { gv[q] = ((const GAS f32x4*)g)[F.lane + 64 * q]; bv[q] = ((const GAS f32x4*)bb)[F.lane + 64 * q]; }
    for (int m = gw; m < M; m += NGW) {
        const GAS f32x4* xr = (const GAS f32x4*)(xin + (size_t)m * D) + F.lane;
        const GAS f32x4* yr = (const GAS f32x4*)(Y + (size_t)m * D) + F.lane;
        f32x4 v[4]; float s = 0.f;
#pragma unroll
        for (int q = 0; q < 4; ++q) { v[q] = xr[64 * q] * ALPHA + yr[64 * q]; s += (v[q].x + v[q].y) + (v[q].z + v[q].w); }
        const float mean = wave_sum(s) * (1.f / D); float s2 = 0.f;
#pragma unroll
        for (int q = 0; q < 4; ++q) { v[q] = v[q] - mean; s2 += (v[q].x * v[q].x + v[q].y * v[q].y) + (v[q].z * v[q].z + v[q].w * v[q].w); }
        const float rstd = 1.f / sqrtf(wave_sum(s2) * (1.f / D) + LN_EPS);
        GAS f32x4* orow = (GAS f32x4*)(a.out + (size_t)m * D) + F.lane;
        GAS unsigned long long* o8 = (GAS unsigned long long*)(XB + (size_t)m * D) + F.lane;
#pragma unroll
        for (int q = 0; q < 4; ++q) { const f32x4 o = v[q] * rstd * gv[q] + bv[q]; orow[64 * q] = o;
            o8[64 * q] = (unsigned long long)pk2(o.x, o.y) | ((unsigned long long)pk2(o.z, o.w) << 32); }
    }
}

__device__ __forceinline__ void ph_conv(const Args& a, Frame& F, int L) {
    const bf16* H = (const bf16*)(a.ws + WS_H); bf16* ACT = (bf16*)(a.ws + WS_ACT);
    const float* cw = a.in[12] + (size_t)L * 3 * FF2; const float* cb = a.in[13] + (size_t)L * FF2;
    constexpr int CPR = FF / 8;
    const long total = (long)M * CPR, nthr = (long)F.G * NWAVES * 64;
    for (long idx = (long)F.vcu * NWAVES * 64 + F.tid; idx < total; idx += nthr) {
        const int row = (int)(idx / CPR), ch = (int)(idx % CPR), col = ch * 8, t = row % SEQ;
        float uo[8], go[8];
#pragma unroll
        for (int e = 0; e < 8; ++e) { uo[e] = cb[col + e]; go[e] = cb[FF + col + e]; }
#pragma unroll
        for (int k = 0; k < 3; ++k) {
            const int tt = t + k - 1; if (tt < 0 || tt >= SEQ) continue;
            const bf16* hp = H + (size_t)(row + k - 1) * FF2 + col;
            const bf16x8 hu = *(const bf16x8*)hp, hg = *(const bf16x8*)(hp + FF);
#pragma unroll
            for (int e = 0; e < 8; ++e) { uo[e] += cw[(size_t)k * FF2 + col + e] * bf2f((unsigned short)hu[e]); go[e] += cw[(size_t)k * FF2 + FF + col + e] * bf2f((unsigned short)hg[e]); }
        }
        v4u o; float r[8];
#pragma unroll
        for (int e = 0; e < 8; ++e) r[e] = uo[e] * (0.5f * go[e] * (1.0f + erff(go[e] * 0.70710678118654752f)));
        o.x = pk2(r[0], r[1]); o.y = pk2(r[2], r[3]); o.z = pk2(r[4], r[5]); o.w = pk2(r[6], r[7]);
        *(GAS v4u*)(ACT + (size_t)row * FF + col) = o;
    }
}

__device__ __forceinline__ void diff_scores(const bf16* kp, const LAS float* qs, float& s1, float& s2) {
    s1 = 0.f; s2 = 0.f;
    asm volatile("" ::: "memory");
#pragma unroll 4
    for (int c = 0; c < 16; ++c) {
        asm volatile("" ::: "memory");
        const bf16x8 kv = *(const bf16x8*)(kp + c * 8);
        const f32x4 q0 = *(const LAS f32x4*)(qs + c * 8), q1 = *(const LAS f32x4*)(qs + c * 8 + 4);
        float acc = q0.x * bf2f((unsigned short)kv[0]) + q0.y * bf2f((unsigned short)kv[1]) + q0.z * bf2f((unsigned short)kv[2]) + q0.w * bf2f((unsigned short)kv[3])
                  + q1.x * bf2f((unsigned short)kv[4]) + q1.y * bf2f((unsigned short)kv[5]) + q1.z * bf2f((unsigned short)kv[6]) + q1.w * bf2f((unsigned short)kv[7]);
        if (c < 8) s1 += acc; else s2 += acc;
    }
}
__device__ __forceinline__ void naive_diff_attn(const Args& a, Frame& F, int L) {
    const int gw = F.vcu * NWAVES + F.wave, NGW = F.G * NWAVES, lane = F.lane;
    const int j = L >> 1;
    const float lam_init = (L == 0) ? 0.2f : 0.47071301834358416f;
    const float* lf = a.in[3] + (size_t)j * 4 * 64;
    const float lam = expf(wave_sum(lf[lane] * lf[64 + lane])) - expf(wave_sum(lf[128 + lane] * lf[192 + lane])) + lam_init;
    const float* sg = a.in[4] + (size_t)j * 128;
    const float g0 = sg[lane], g1 = sg[64 + lane];
    const bf16* Q = (const bf16*)(a.ws + WS_Q); const bf16* K = (const bf16*)(a.ws + WS_K); const bf16* V = (const bf16*)(a.ws + WS_V); bf16* O = (bf16*)(a.ws + WS_O);
    LAS float* qs = (LAS float*)(F.lds + RING_OFF) + F.wave * 128;
    for (int task = gw; task < M * 8; task += NGW) {
        const int h = task & 7, row = task >> 3, b = row / SEQ, t = row % SEQ;
        const bf16* qp = Q + (size_t)row * D + h * 128;
        qs[lane] = bf2f(qp[lane]); qs[64 + lane] = bf2f(qp[64 + lane]);
        LDS_WAIT(); asm volatile("" ::: "memory");
        const float c2 = exp2f(-(float)(h + 1)) * LOG2E;
        const bf16* Kb = K + (size_t)b * SEQ * D + h * 128; const bf16* Vb = V + (size_t)b * SEQ * D + h * 128;
        float m1 = -1e30f, l1 = 0.f, m2 = -1e30f, l2 = 0.f;
        for (int tile = 0; tile < SEQ / 64; ++tile) {
            const int s = tile * 64 + lane; float s1, s2; diff_scores(Kb + (size_t)s * D, qs, s1, s2);
            const float pen = c2 * fabsf((float)(t - s)); s1 -= pen; s2 -= pen;
            float mn = fmaxf(m1, s1); l1 = l1 * exp2f(m1 - mn) + exp2f(s1 - mn); m1 = mn;
            mn = fmaxf(m2, s2); l2 = l2 * exp2f(m2 - mn) + exp2f(s2 - mn); m2 = mn;
        }
        const float M1 = wave_max(m1), M2 = wave_max(m2);
        const float i1 = 1.f / wave_sum(l1 * exp2f(m1 - M1)), i2 = lam / wave_sum(l2 * exp2f(m2 - M2));
        float o0 = 0.f, o1 = 0.f;
        for (int tile = 0; tile < SEQ / 64; ++tile) {
            const int s = tile * 64 + lane; float s1, s2; diff_scores(Kb + (size_t)s * D, qs, s1, s2);
            const float pen = c2 * fabsf((float)(t - s)); s1 -= pen; s2 -= pen;
            const float av = exp2f(s1 - M1) * i1 - exp2f(s2 - M2) * i2;
            const bf16* vp = Vb + (size_t)(tile * 64) * D + lane;
#pragma unroll 8
            for (int jj = 0; jj < 64; ++jj) { const float aj = __shfl(av, jj); o0 += aj * bf2f(vp[(size_t)jj * D]); o1 += aj * bf2f(vp[(size_t)jj * D + 64]); }
        }
        const float ms = wave_sum(o0 * o0 + o1 * o1) * (1.f / 128.f);
        const float r = (1.f / sqrtf(ms + RMS_EPS)) * (1.f - lam_init);
        bf16* op = O + (size_t)row * D + h * 128;
        op[lane] = (bf16)f2bf(o0 * r * g0); op[64 + lane] = (bf16)f2bf(o1 * r * g1);
        asm volatile("" ::: "memory");
    }
}

__device__ __forceinline__ void naive_na_attn(const Args& a, Frame& F, int L) {
    const int gw = F.vcu * NWAVES + F.wave, NGW = F.G * NWAVES, lane = F.lane;
    const int j = L >> 1;
    const float* rpb = a.in[7] + (size_t)j * 16 * 15 * 31;
    const bf16* Q = (const bf16*)(a.ws + WS_Q); const bf16* K = (const bf16*)(a.ws + WS_K); const bf16* V = (const bf16*)(a.ws + WS_V); bf16* O = (bf16*)(a.ws + WS_O);
    LAS float* qs = (LAS float*)(F.lds + RING_OFF) + F.wave * 128;
    for (int task = gw; task < M * 16; task += NGW) {
        const int h = task & 15, row = task >> 4, b = row / SEQ, t = row % SEQ, r = t >> 6, c = t & 63;
        const int rs = min(max(r - 4, 0), 56), cs = min(max(c - 8, 0), 48);
        qs[lane] = bf2f(Q[(size_t)row * D + h * 64 + lane]);
        LDS_WAIT(); asm volatile("" ::: "memory");
        const bf16* Kb = K + (size_t)b * SEQ * D + h * 64; const bf16* Vb = V + (size_t)b * SEQ * D + h * 64;
        float sc[2];
#pragma unroll
        for (int hf = 0; hf < 2; ++hf) {
            const int kk = lane + 64 * hf, i = kk >> 4, jj = kk & 15, kt = (rs + i) * 64 + cs + jj;
            const bf16* kp = Kb + (size_t)kt * D; float acc = 0.f;
#pragma unroll
            for (int cc = 0; cc < 8; ++cc) { const bf16x8 kv = *(const bf16x8*)(kp + cc * 8);
#pragma unroll
                for (int e = 0; e < 8; ++e) acc += qs[cc * 8 + e] * bf2f((unsigned short)kv[e]); }
            sc[hf] = acc + rpb[((size_t)h * 15 + (rs + i - r + 7)) * 31 + (cs + jj - c + 15)] * LOG2E;
        }
        const float mx = wave_max(fmaxf(sc[0], sc[1]));
        const float p0 = exp2f(sc[0] - mx), p1 = exp2f(sc[1] - mx);
        const float inv = 1.f / wave_sum(p0 + p1);
        float o = 0.f;
#pragma unroll 8
        for (int kk = 0; kk < 128; ++kk) { const int i = kk >> 4, jj = kk & 15, kt = (rs + i) * 64 + cs + jj;
            const float pk = __shfl(kk < 64 ? p0 : p1, kk & 63); o += pk * bf2f(Vb[(size_t)kt * D + lane]); }
        O[(size_t)row * D + h * 64 + lane] = (bf16)f2bf(o * inv);
        asm volatile("" ::: "memory");
    }
}

template <int S> __device__ __forceinline__ void run_phase(const Args& args, Frame& F0, int L) {
    Frame F = F0; { int t_ = threadIdx.x; asm volatile("" : "+v"(t_)); F.tid = t_; F.lane = t_ & 63; F.wave = __builtin_amdgcn_readfirstlane(t_ >> 6); }
    const int j = L >> 1; const bool na = (L & 1) != 0;
    bf16* WQKV = (bf16*)(args.ws + WS_WQKV); bf16* WO = (bf16*)(args.ws + WS_WO); bf16* WIN = (bf16*)(args.ws + WS_WIN); bf16* WOUT = (bf16*)(args.ws + WS_WOUT);
    bf16* XB = (bf16*)(args.ws + WS_XB); bf16* ACT = (bf16*)(args.ws + WS_ACT); bf16* HB = (bf16*)(args.ws + WS_H);
    bf16* QB = (bf16*)(args.ws + WS_Q); bf16* OB = (bf16*)(args.ws + WS_O); float* Y = (float*)(args.ws + WS_Y);
    if constexpr (S == 0) ph_convert(args, F, L);
    else if constexpr (S == 1) {
        pg8::Gemm g{XB, WQKV, M, NQKV, D}; pg8::StaticOrder So; So.init(M, NQKV, F.G, (int)blockIdx.x);
        pg8::EpiBf16<0> E{QB, D, na ? args.in[6] + (size_t)j * NQKV : nullptr, D, (size_t)(WS_K - WS_Q) / 2, QSCALE};
        pg8::gemm_phase<pg8::EpiBf16<0>, pg8::StaticOrder, PG8_ALIGN, PG8_SP2>(F.lds + RING_OFF, g, So, E);
    }
    else if constexpr (S == 2) { if (na) naive_na_attn(args, F, L); else naive_diff_attn(args, F, L); }
    else if constexpr (S == 3) {
        pg8::Gemm g{OB, WO, M, D, D}; pg8::StaticOrder So; So.init(M, D, F.G, (int)blockIdx.x);
        pg8::EpiF32 E{Y, D, na ? args.in[9] + (size_t)j * D : nullptr};
        pg8::gemm_phase<pg8::EpiF32, pg8::StaticOrder, PG8_ALIGN, PG8_SP2>(F.lds + RING_OFF, g, So, E);
    }
    else if constexpr (S == 4) ph_ln(args, F, L, 0);
    else if constexpr (S == 5) {
        pg8::Gemm g{XB, WIN, M, FF2, D}; pg8::StaticOrder So; So.init(M, FF2, F.G, (int)blockIdx.x);
        pg8::EpiBf16<0> E{HB, FF2, args.in[11] + (size_t)L * FF2, 0, 0, 1.f};
        pg8::gemm_phase<pg8::EpiBf16<0>, pg8::StaticOrder, PG8_ALIGN, PG8_SP2>(F.lds + RING_OFF, g, So, E);
    }
    else if constexpr (S == 6) ph_conv(args, F, L);
    else if constexpr (S == 7) {
        pg8::Gemm g{ACT, WOUT, M, D, FF}; pg8::StaticOrder So; So.init(M, D, F.G, (int)blockIdx.x);
        pg8::EpiF32 E{Y, D, args.in[15] + (size_t)L * D};
        pg8::gemm_phase<pg8::EpiF32, pg8::StaticOrder, PG8_ALIGN, PG8_SP2>(F.lds + RING_OFF, g, So, E);
    }
    else ph_ln(args, F, L, 1);
}
__device__ __forceinline__ void frame_init(Frame& F, const Args& args, unsigned char* lds) {
    F.lds = (LAS unsigned char*)lds;
    F.MISC = (volatile LAS unsigned*)(F.lds + MISC_OFF);
    F.tid = threadIdx.x; F.lane = F.tid & 63; F.wave = __builtin_amdgcn_readfirstlane(F.tid >> 6);
    F.G = gridDim.x; { const int bx = blockIdx.x; F.vcu = (F.G % 8 == 0) ? (bx % 8) * (F.G / 8) + bx / 8 : bx; }
    F.ctl = (gu32*)(args.ws + WS_CTL);
}
template <int S> __global__ void __launch_bounds__(NWAVES * 64, 2) phase_kernel(Args args) {
    extern __shared__ __attribute__((aligned(16))) unsigned char lds[];
    Frame F; frame_init(F, args, lds);
    run_phase<S>(args, F, args.ph_lo);
}

__global__ void __launch_bounds__(NWAVES * 64, 2) fwd_kernel(Args args) {
    extern __shared__ __attribute__((aligned(16))) unsigned char lds[];
    Frame F; frame_init(F, args, lds);
    for (int u = F.tid; u < (LDS_BYTES - LDSCTL_OFF) / 4; u += NWAVES * 64) ((LAS unsigned*)(F.lds + LDSCTL_OFF))[u] = 0u;
    __syncthreads();
    XcdBarrier bar = xcd_barrier_post((unsigned*)(F.ctl + CW_BAR), F.MISC + 8);
    const int lo = args.ph_lo, hi = args.ph_hi;
    for (int p = lo; p < hi; ++p) {
        const int L = p / PH_PER_LAYER, s = p % PH_PER_LAYER;
        switch (s) {
            case 0: run_phase<0>(args, F, L); break;
            case 1: run_phase<1>(args, F, L); break;
            case 2: run_phase<2>(args, F, L); break;
            case 3: run_phase<3>(args, F, L); break;
            case 4: run_phase<4>(args, F, L); break;
            case 5: run_phase<5>(args, F, L); break;
            case 6: run_phase<6>(args, F, L); break;
            case 7: run_phase<7>(args, F, L); break;
            default: run_phase<8>(args, F, L); break;
        }
        if (p + 1 < hi) xcd_barrier(bar);
    }
}

template <int S> static void launch_phase(int grid, Args a, int L, hipStream_t stream) {
    static bool attr = false;
    if (!attr) { (void)hipFuncSetAttribute((const void*)phase_kernel<S>, hipFuncAttributeMaxDynamicSharedMemorySize, LDS_BYTES); attr = true; }
    a.ph_lo = L; a.ph_hi = S;
    hipLaunchKernelGGL(phase_kernel<S>, dim3(grid), dim3(NWAVES * 64), LDS_BYTES, stream, a);
}
extern "C" void kernel_launch(void* const* d_in, const int* in_sizes, int n_in, void* d_out, int out_size, void* d_ws, size_t ws_size, hipStream_t stream) {
    static int grid = 0;
    if (grid == 0) {
        if (n_in != 18 || in_sizes[0] != M * D || out_size != M * D || ws_size < WS_END) { fprintf(stderr, "kernel_launch: unexpected shapes (n_in %d, in0 %d, out %d, ws %zu)\n", n_in, n_in > 0 ? in_sizes[0] : -1, out_size, ws_size); grid = -1; return; }
        int dev = 0, cus = 0;
        if (hipGetDevice(&dev) != hipSuccess || hipDeviceGetAttribute(&cus, hipDeviceAttributeMultiprocessorCount, dev) != hipSuccess) { grid = -1; return; }
        grid = cus;
    }
    if (grid < 0) return;
    (void)hipMemsetAsync((char*)d_ws + WS_CTL, 0, CTL_ZERO_BYTES, stream);
    Args a{};
    for (int i = 0; i < 18; ++i) a.in[i] = (const float*)d_in[i];
    a.out = (float*)d_out; a.ws = (unsigned char*)d_ws;
#if MK_ONE_LAUNCH
    static bool attr1 = false;
    if (!attr1) { (void)hipFuncSetAttribute((const void*)fwd_kernel, hipFuncAttributeMaxDynamicSharedMemorySize, LDS_BYTES); attr1 = true; }
    a.ph_lo = 0; a.ph_hi = N_PHASES;
    hipLaunchKernelGGL(fwd_kernel, dim3(grid), dim3(NWAVES * 64), LDS_BYTES, stream, a);
#else
    for (int L = 0; L < DEPTH; ++L) {
        launch_phase<0>(grid, a, L, stream); launch_phase<1>(grid, a, L, stream); launch_phase<2>(grid, a, L, stream);
        launch_phase<3>(grid, a, L, stream); launch_phase<4>(grid, a, L, stream); launch_phase<5>(grid, a, L, stream);
        launch_phase<6>(grid, a, L, stream); launch_phase<7>(grid, a, L, stream); launch_phase<8>(grid, a, L, stream);
    }
#endif
}
```

```cpp
#include <hip/hip_runtime.h>
#include <cstdio>
#include <cstdint>
namespace pg8 {
#define PG8_LAS __attribute__((address_space(3)))
typedef unsigned short bf16_t;
typedef short bf16x8 __attribute__((ext_vector_type(8)));
typedef float f32x4 __attribute__((ext_vector_type(4)));
typedef unsigned u32x4 __attribute__((ext_vector_type(4)));
constexpr int BM = 256, BK = 64, HALF = 128, HTB = HALF * BK * 2  , STAGE_BYTES = 8 * HTB, NXCD = 8, WGM = 8;

__host__ __device__ __forceinline__ int lds_byte(int r, int c) { const int st = (r >> 4) * 2 + (c >> 5), rr = r & 15, cc = c & 31, ob = rr * 64 + cc * 2; return st * 1024 + (ob ^ (((ob >> 9) & 1) << 5)); }
__host__ __device__ __forceinline__ void stage_rc(int b, int& R, int& C) { const int st = b / 1024, sb = b % 1024, swz = sb ^ (((sb >> 9) & 1) << 5); R = (st >> 1) * 16 + swz / 64; C = (st & 1) * 32 + (swz % 64) / 2; }
__host__ __device__ __forceinline__ int perm32(int rho) { const int n = rho >> 4, i = rho & 15; return 8 * (i >> 2) + 4 * n + (i & 3); }

struct Unit { int pm, pn; };
struct Gemm { const bf16_t* A; const bf16_t* Bt; int M, N, K; };

struct StaticOrder {
    int nM, nN, nwg, G, c;
    __host__ __device__ void init(int M, int N, int G_, int c_) { nM = M / BM; nN = N / BM; nwg = nM * nN; G = G_; c = c_; }
    __host__ __device__ bool next(int i, Unit& u) const {
        const long L = (long)i * G + c; if (L >= nwg) return false;
        int wgid = (int)L; { const int q = nwg / NXCD, r = nwg % NXCD, xcd = wgid % NXCD, off = wgid / NXCD; wgid = (xcd < r ? xcd * (q + 1) : r * (q + 1) + (xcd - r) * q) + off; }
        const int nig = WGM * nN, gid = wgid / nig, fm = gid * WGM, gsz = (nM - fm) < WGM ? (nM - fm) : WGM;
        u.pm = fm + ((wgid % nig) % gsz); u.pn = (wgid % nig) / gsz; return true;
    }
    __device__ __forceinline__ void a_ready(const Unit&) const {}
    __device__ __forceinline__ void done(const Unit&) const {}
};

__device__ __forceinline__ unsigned cvt_pk_bf16(float lo, float hi) { unsigned r; asm volatile("v_cvt_pk_bf16_f32 %0, %1, %2" : "=v"(r) : "v"(lo), "v"(hi)); return r; }
typedef float f32x2 __attribute__((ext_vector_type(2)));
__device__ __forceinline__ f32x2 gelu_pk(f32x2 v) {
    const f32x2 av = __builtin_elementwise_abs(v), d = av * 0.2316418882f + 1.0f;
    f32x2 t; t.x = __builtin_amdgcn_rcpf(d.x); t.y = __builtin_amdgcn_rcpf(d.y);
    f32x2 q = t * 0.5307027145f + (-0.7265760135f); q = q * t + 0.7107068705f; q = q * t + (-0.142248368f); q = q * t + 0.127414796f; q = q * t;
    const f32x2 s = (v * v) * (-0.72134752044f);
    f32x2 e; e.x = __builtin_amdgcn_exp2f(s.x); e.y = __builtin_amdgcn_exp2f(s.y);
    const f32x2 m = v * (q * e), r = v - m;
    f32x2 o; o.x = v.x < 0.f ? m.x : r.x; o.y = v.y < 0.f ? m.y : r.y; return o;
}

template <int ACT  > struct EpiBf16 {
    static constexpr bool PERM = true, AFTER_DRAIN = false; static_assert(ACT == 0 || ACT == 1, "EpiBf16: ACT is 0 (none) or 1 (gelu_pk)");
    bf16_t* O; int ldc; const float* bias; int split_cols; size_t split_stride; float scale0;
    __device__ __forceinline__ void operator()(const f32x4 (&acc)[2][2][4][2], const Unit& u, int wr, int wc, int fr, int fq) const {
        const int row0 = u.pm * BM + wr * 64 + fr; int colt = u.pn * BM; bf16_t* base = O;
        float sc = 1.f; if (split_cols) { const int t = colt / split_cols; base += (size_t)t * split_stride; colt -= t * split_cols; if (t == 0) sc = scale0; }
        const int col0 = colt + wc * 32 + 8 * fq, bcol0 = u.pn * BM + wc * 32 + 8 * fq;
        f32x4 bv[2][2];
#pragma unroll
        for (int bj = 0; bj < 2; ++bj)
#pragma unroll
            for (int n = 0; n < 2; ++n) bv[bj][n] = bias ? *(const f32x4*)(bias + bcol0 + bj * HALF + 4 * n) : (f32x4){0.f, 0.f, 0.f, 0.f};
#pragma unroll
        for (int ai = 0; ai < 2; ++ai)
#pragma unroll
            for (int m = 0; m < 4; ++m) { bf16_t* rowp = base + (size_t)(row0 + ai * HALF + m * 16) * ldc + col0;
#pragma unroll
                for (int bj = 0; bj < 2; ++bj) { f32x4 v0 = acc[ai][bj][m][0] + bv[bj][0], v1 = acc[ai][bj][m][1] + bv[bj][1];
                    if (ACT == 1) { f32x2 a = gelu_pk((f32x2){v0[0], v0[1]}), b = gelu_pk((f32x2){v0[2], v0[3]}), c = gelu_pk((f32x2){v1[0], v1[1]}), d = gelu_pk((f32x2){v1[2], v1[3]});
                        v0 = (f32x4){a.x, a.y, b.x, b.y}; v1 = (f32x4){c.x, c.y, d.x, d.y}; }
                    v0 = v0 * sc; v1 = v1 * sc; u32x4 w; w.x = cvt_pk_bf16(v0[0], v0[1]); w.y = cvt_pk_bf16(v0[2], v0[3]); w.z = cvt_pk_bf16(v1[0], v1[1]); w.w = cvt_pk_bf16(v1[2], v1[3]);
                    *(u32x4*)(rowp + bj * HALF) = w; } }
    }
};
struct EpiF32 {
    static constexpr bool PERM = false, AFTER_DRAIN = false;
    float* C; int ldc; const float* bias;
    __device__ __forceinline__ void operator()(const f32x4 (&acc)[2][2][4][2], const Unit& u, int wr, int wc, int fr, int fq) const {
        const int row0 = u.pm * BM + wr * 64 + fr, col0 = u.pn * BM + wc * 32 + 4 * fq;
        f32x4 bv[2][2];
#pragma unroll
        for (int bj = 0; bj < 2; ++bj)
#pragma unroll
            for (int n = 0; n < 2; ++n) bv[bj][n] = bias ? *(const f32x4*)(bias + col0 + bj * HALF + n * 16) : (f32x4){0.f, 0.f, 0.f, 0.f};
#pragma unroll
        for (int ai = 0; ai < 2; ++ai)
#pragma unroll
            for (int m = 0; m < 4; ++m) { float* rowp = C + (size_t)(row0 + ai * HALF + m * 16) * ldc + col0;
#pragma unroll
                for (int bj = 0; bj < 2; ++bj)
#pragma unroll
                    for (int n = 0; n < 2; ++n) *(f32x4*)(rowp + bj * HALF + n * 16) = acc[ai][bj][m][n] + bv[bj][n]; }
    }
};
template <class Epi, class Sched, bool ALIGN_EPI = false, bool SP2 = false>
__device__ __forceinline__ void gemm_phase(PG8_LAS unsigned char* lds, const Gemm g, const Sched& S, const Epi& E) {
    int tid_ = threadIdx.x; asm volatile("" : "+v"(tid_));
    const int tid = tid_, wid = __builtin_amdgcn_readfirstlane(tid >> 6), lane = tid & 63, wr = wid >> 2, wc = wid & 3, fr = lane & 15, fq = lane >> 4;
    const int K = g.K, nt = K / BK;
    unsigned voffA[2], voffB[2];
#pragma unroll
    for (int i = 0; i < 2; ++i) { int R, C; stage_rc(tid * 16 + i * 8192, R, C); const int Rb = Epi::PERM ? ((R & ~31) + perm32(R & 31)) : R;
        voffA[i] = (unsigned)(R * K + C) * 2u; voffB[i] = (unsigned)(Rb * K + C) * 2u; }
    const size_t kstep = (size_t)(BK * 2);
    const size_t hstep = (size_t)HALF * K * 2;
    const size_t tstep = 2 * hstep;
    const unsigned ldsw = (unsigned)wid * 1024u;
    const int aoff = lds_byte(wr * 64 + fr, fq * 8), boff = lds_byte(wc * 32 + fr, fq * 8);
#define PG8_SA(b, h) (((b) * 2 + (h)) * HTB)
#define PG8_SB(b, h) ((4 + (b) * 2 + (h)) * HTB)
#define PG8_STAGE(bufoff, gbase, voff) do { _Pragma("unroll") for (int _i = 0; _i < 2; ++_i) \
        __builtin_amdgcn_global_load_lds((const unsigned*)((const char*)(gbase) + (voff)[_i]), (PG8_LAS unsigned*)(lds + (bufoff) + ldsw + _i * 8192), 16, 0, 0); } while (0)
#define PG8_LDA(dst, b, h) do { _Pragma("unroll") for (int m = 0; m < 4; ++m) _Pragma("unroll") for (int k = 0; k < 2; ++k) dst[m][k] = *(const PG8_LAS bf16x8*)(lds + PG8_SA(b, h) + aoff + m * 2048 + k * 1024); } while (0)
#define PG8_LDB(dst, b, h) do { _Pragma("unroll") for (int n = 0; n < 2; ++n) _Pragma("unroll") for (int k = 0; k < 2; ++k) dst[n][k] = *(const PG8_LAS bf16x8*)(lds + PG8_SB(b, h) + boff + n * 2048 + k * 1024); } while (0)
#define PG8_MMA(ai, bj, At, Bt) do { __builtin_amdgcn_s_setprio(1); _Pragma("unroll") for (int m = 0; m < 4; ++m) _Pragma("unroll") for (int n = 0; n < 2; ++n) _Pragma("unroll") for (int k = 0; k < 2; ++k) \
        acc[ai][bj][m][n] = __builtin_amdgcn_mfma_f32_16x16x32_bf16(Bt[n][k], At[m][k], acc[ai][bj][m][n], 0, 0, 0); __builtin_amdgcn_s_setprio(0); } while (0)
#define PG8_WAIT_V(n) asm volatile("s_waitcnt vmcnt(" #n ")" ::: "memory")
#define PG8_WAIT_L(n) asm volatile("s_waitcnt lgkmcnt(" #n ")" ::: "memory")
#define PG8_BAR __builtin_amdgcn_s_barrier()
#define PG8_SCHED __builtin_amdgcn_sched_barrier(0)
    Unit cur, nxt; int ui = 0;
    if (!S.next(0, cur)) return;
    f32x4 acc[2][2][4][2];
#pragma unroll
    for (int a = 0; a < 2; ++a)
#pragma unroll
        for (int b = 0; b < 2; ++b)
#pragma unroll
            for (int m = 0; m < 4; ++m)
#pragma unroll
                for (int n = 0; n < 2; ++n) acc[a][b][m][n] = (f32x4){0.f, 0.f, 0.f, 0.f};
    bf16x8 At[4][2], B0[2][2], B1[2][2];
    const char* cA = (const char*)g.A + (size_t)cur.pm * tstep; const char* cB = (const char*)g.Bt + (size_t)cur.pn * tstep;
    S.a_ready(cur);
    if constexpr (SP2) {
        PG8_STAGE(PG8_SB(0, 0), cB, voffB); PG8_STAGE(PG8_SB(0, 1), cB + hstep, voffB); PG8_STAGE(PG8_SA(0, 0), cA, voffA); PG8_STAGE(PG8_SA(0, 1), cA + hstep, voffA);
        if (wr == 1) PG8_BAR;
        PG8_WAIT_V(2); PG8_BAR;
        PG8_STAGE(PG8_SB(1, 0), cB + kstep, voffB); PG8_STAGE(PG8_SA(1, 0), cA + kstep, voffA); PG8_STAGE(PG8_SB(1, 1), cB + hstep + kstep, voffB);
        PG8_WAIT_V(6); PG8_BAR;
    } else {
        PG8_STAGE(PG8_SB(0, 0), cB, voffB); PG8_STAGE(PG8_SA(0, 0), cA, voffA); PG8_STAGE(PG8_SB(0, 1), cB + hstep, voffB); PG8_STAGE(PG8_SA(0, 1), cA + hstep, voffA);
        if (wr == 1) PG8_BAR;
        PG8_WAIT_V(4); PG8_BAR;
        PG8_STAGE(PG8_SB(1, 0), cB + kstep, voffB); PG8_STAGE(PG8_SA(1, 0), cA + kstep, voffA); PG8_STAGE(PG8_SB(1, 1), cB + hstep + kstep, voffB);
        PG8_WAIT_V(6); PG8_BAR;
    }
    for (;;) {
        const bool has_next = S.next(ui + 1, nxt);
        const char* nA = has_next ? (const char*)g.A + (size_t)nxt.pm * tstep : cA; const char* nB = has_next ? (const char*)g.Bt + (size_t)nxt.pn * tstep : cB;
        for (int t = 0; t < nt; t += 2) {
            const bool last = (t == nt - 2);
            const char* a1 = cA + (size_t)(t + 1) * kstep;
            const char* a2 = last ? nA : cA + (size_t)(t + 2) * kstep; const char* b2 = last ? nB : cB + (size_t)(t + 2) * kstep;
            const char* a3 = a2 + kstep; const char* b3 = b2 + kstep;
            if (last && has_next) S.a_ready(nxt);
            if constexpr (SP2) {
            PG8_LDB(B0, 0, 0); PG8_LDB(B1, 0, 1); PG8_SCHED; PG8_LDA(At, 0, 0); PG8_STAGE(PG8_SA(1, 1), a1 + hstep, voffA);
            PG8_WAIT_V(8); PG8_WAIT_L(0); PG8_BAR; PG8_MMA(0, 0, At, B0); PG8_MMA(0, 1, At, B1); PG8_BAR; PG8_SCHED;
            PG8_LDA(At, 0, 1); PG8_STAGE(PG8_SB(0, 0), b2, voffB); PG8_STAGE(PG8_SB(0, 1), b2 + hstep, voffB); PG8_STAGE(PG8_SA(0, 0), a2, voffA);
            PG8_WAIT_V(8); PG8_WAIT_L(0); PG8_BAR; PG8_MMA(1, 0, At, B0); PG8_MMA(1, 1, At, B1); PG8_BAR; PG8_SCHED;
            PG8_LDB(B0, 1, 0); PG8_LDB(B1, 1, 1); PG8_SCHED; PG8_LDA(At, 1, 0); PG8_STAGE(PG8_SA(0, 1), a2 + hstep, voffA);
            PG8_WAIT_V(8); PG8_WAIT_L(0); PG8_BAR; PG8_MMA(0, 0, At, B0); PG8_MMA(0, 1, At, B1); PG8_BAR; PG8_SCHED;
            PG8_LDA(At, 1, 1); PG8_STAGE(PG8_SB(1, 0), b3, voffB); PG8_STAGE(PG8_SB(1, 1), b3 + hstep, voffB); PG8_STAGE(PG8_SA(1, 0), a3, voffA);
            PG8_WAIT_V(8); PG8_WAIT_L(0); PG8_BAR; PG8_MMA(1, 0, At, B0); PG8_MMA(1, 1, At, B1); PG8_BAR; PG8_SCHED;
            } else {
            PG8_LDB(B0, 0, 0); PG8_SCHED; PG8_LDA(At, 0, 0); PG8_STAGE(PG8_SA(1, 1), a1 + hstep, voffA);
            PG8_WAIT_L(8); PG8_BAR; PG8_WAIT_L(0); PG8_MMA(0, 0, At, B0); PG8_BAR; PG8_SCHED;
            PG8_LDB(B1, 0, 1); PG8_STAGE(PG8_SB(0, 0), b2, voffB);
            PG8_BAR; PG8_WAIT_L(0); PG8_MMA(0, 1, At, B1); PG8_BAR;
            PG8_LDA(At, 0, 1); PG8_STAGE(PG8_SA(0, 0), a2, voffA);
            PG8_BAR; PG8_WAIT_L(0); PG8_MMA(1, 0, At, B0); PG8_BAR; PG8_SCHED;
            PG8_STAGE(PG8_SB(0, 1), b2 + hstep, voffB);
            PG8_WAIT_V(6); PG8_BAR; PG8_MMA(1, 1, At, B1); PG8_BAR;
            PG8_LDB(B0, 1, 0); PG8_SCHED; PG8_LDA(At, 1, 0); PG8_STAGE(PG8_SA(0, 1), a2 + hstep, voffA);
            PG8_WAIT_L(8); PG8_BAR; PG8_WAIT_L(0); PG8_MMA(0, 0, At, B0); PG8_BAR; PG8_SCHED;
            PG8_LDB(B1, 1, 1); PG8_STAGE(PG8_SB(1, 0), b3, voffB);
            PG8_BAR; PG8_WAIT_L(0); PG8_MMA(0, 1, At, B1); PG8_BAR;
            PG8_LDA(At, 1, 1); PG8_STAGE(PG8_SA(1, 0), a3, voffA);
            PG8_BAR; PG8_WAIT_L(0); PG8_MMA(1, 0, At, B0); PG8_BAR; PG8_SCHED;
            PG8_STAGE(PG8_SB(1, 1), b3 + hstep, voffB);
            PG8_WAIT_V(6); PG8_BAR; PG8_MMA(1, 1, At, B1); PG8_BAR;
            }
        }
        if constexpr (ALIGN_EPI) { if (wr == 0) PG8_BAR; }
        if constexpr (!Epi::AFTER_DRAIN) { E(acc, cur, wr, wc, fr, fq); S.done(cur); }
        if (!has_next) break;
#pragma unroll
        for (int a = 0; a < 2; ++a)
#pragma unroll
            for (int b = 0; b < 2; ++b)
#pragma unroll
                for (int m = 0; m < 4; ++m)
#pragma unroll
                    for (int n = 0; n < 2; ++n) acc[a][b][m][n] = (f32x4){0.f, 0.f, 0.f, 0.f};
        cur = nxt; cA = nA; cB = nB; ++ui;
        if constexpr (ALIGN_EPI) { if (wr == 1) PG8_BAR; }
    }
    PG8_WAIT_V(0);
    if constexpr (!ALIGN_EPI) { if (wr == 0) PG8_BAR; }
    PG8_BAR;
    if constexpr (Epi::AFTER_DRAIN) { E.fused(acc, cur, wr, wc, fr, fq, lds, wid, lane); S.done(cur); }
#undef PG8_SA
#undef PG8_SB
#undef PG8_STAGE
#undef PG8_LDA
#undef PG8_LDB
#undef PG8_MMA
#undef PG8_WAIT_V
#undef PG8_WAIT_L
#undef PG8_BAR
#undef PG8_SCHED
}
}

#ifndef PG8_SP2
#define PG8_SP2 true
#endif
#ifndef PG8_ALIGN
#define PG8_ALIGN true
#endif

constexpr int NWAVES = 8;
constexpr int BATCH = 4, SEQ = 4096, D = 1024, M = BATCH * SEQ, DEPTH = 4;
constexpr int NQKV = 3 * D, FF = 2816, FF2 = 2 * FF;
constexpr float LN_EPS = 1e-5f, RMS_EPS = 1e-5f;
constexpr float LOG2E = 1.4426950408889634f;
constexpr float QSCALE = 0.125f * LOG2E;
constexpr float ALPHA = 1.6817928305074290861f;
constexpr int PH_PER_LAYER = 9, N_PHASES = DEPTH * PH_PER_LAYER;
#ifndef NAIVE_DIFF
#define NAIVE_DIFF 0
#endif
#ifndef MK_ONE_LAUNCH
#define MK_ONE_LAUNCH 1
#endif

constexpr size_t MiB = 1u << 20;
constexpr size_t WS_CTL = 0, CTL_ZERO_BYTES = 1 * MiB;
constexpr size_t WS_WQKV = 2 * MiB, WS_WO = 8 * MiB, WS_WIN = 10 * MiB, WS_WOUT = 21 * MiB;
constexpr size_t WS_XB = 28 * MiB;
constexpr size_t WS_ACT = 60 * MiB;
constexpr size_t WS_H = 148 * MiB;
constexpr size_t WS_Q = 148 * MiB, WS_K = 180 * MiB, WS_V = 212 * MiB, WS_O = 244 * MiB;
constexpr size_t WS_Y = 276 * MiB;
constexpr size_t WS_END = 340 * MiB;
constexpr int CW_BAR = 4096;

constexpr int RING_OFF = 0, RING_BYTES = 131072;
constexpr int LDSCTL_OFF = RING_BYTES, MISC_OFF = LDSCTL_OFF + 320;
constexpr int LDS_BYTES = 147456;

#define GAS __attribute__((address_space(1)))
#define LAS __attribute__((address_space(3)))
typedef unsigned short bf16;
typedef unsigned v4u __attribute__((ext_vector_type(4)));
typedef float f32x4 __attribute__((ext_vector_type(4)));
typedef short bf16x8 __attribute__((ext_vector_type(8)));
typedef GAS unsigned gu32;
typedef GAS unsigned long long gu64;
#define RLX_AGENT __ATOMIC_RELAXED, __HIP_MEMORY_SCOPE_AGENT
#define LDS_WAIT() asm volatile("s_waitcnt lgkmcnt(0)" ::: "memory")
#define VM_WAIT() asm volatile("s_waitcnt vmcnt(0)" ::: "memory")
__device__ __forceinline__ unsigned long long rt() { return __builtin_amdgcn_s_memrealtime(); }
__device__ __forceinline__ unsigned f2bf(float f) { unsigned u = __builtin_bit_cast(unsigned, f); return (u + 0x7fffu + ((u >> 16) & 1u)) >> 16; }
__device__ __forceinline__ unsigned pk2(float lo, float hi) { return f2bf(lo) | (f2bf(hi) << 16); }

#define XB_TMO      128
#define XB_XCNT(j)  (256  + 64 * (j))
#define XB_XSUB(j)  (1280 + 64 * (j))
#define XB_XGEN(j)  (2304 + 64 * (j))
#define XB_TOP      3328
#define XB_TOPGEN   3392
#define XCD_BAR_WORDS 3456
#define XB_SPIN_CAP (1u << 18)

__device__ __forceinline__ unsigned xb_ld(unsigned* p)              { return __hip_atomic_load(p, __ATOMIC_RELAXED, __HIP_MEMORY_SCOPE_AGENT); }
__device__ __forceinline__ unsigned xb_add(unsigned* p, unsigned v) { return __hip_atomic_fetch_add(p, v, __ATOMIC_RELAXED, __HIP_MEMORY_SCOPE_AGENT); }
__device__ __forceinline__ unsigned xb_xcc_id() { return (unsigned)__builtin_amdgcn_s_getreg((3 << 11) | 20) & 0xFu; }
#define XB_SPIN(cond, bar) do { unsigned _sp = 0; while (cond) { __builtin_amdgcn_s_sleep(1); \
    if ((++_sp & 255u) == 0u) { if (xb_ld(&(bar)[XB_TMO])) break; if (_sp > XB_SPIN_CAP) { atomicAdd(&(bar)[XB_TMO], 1u); break; } } } } while (0)

struct XcdBarrier {
    unsigned* bar; unsigned x;
    volatile LAS unsigned* st;
};

__device__ __forceinline__ XcdBarrier xcd_barrier_post(unsigned* bar, volatile LAS unsigned* st) {
    XcdBarrier b; b.bar = bar; b.x = xb_xcc_id(); b.st = st;
    if (threadIdx.x == 0) (void)xb_add(&bar[XB_XCNT(b.x)], 1u);
    return b;
}
__device__ __forceinline__ void xcd_barrier_complete(unsigned* bar, unsigned x, unsigned& nloc, unsigned& nx) {
    const unsigned G = gridDim.x * gridDim.y * gridDim.z;
    unsigned sum, cnt, mine, sp = 0u;
    for (;;) {
        sum = 0u; cnt = 0u; mine = 0u;
#pragma unroll
        for (unsigned j = 0; j < 16; ++j) { const unsigned c = xb_ld(&bar[XB_XCNT(j)]); sum += c; cnt += (c > 0u) ? 1u : 0u; mine = (j == x) ? c : mine; }
        if (sum == G) break;
        __builtin_amdgcn_s_sleep(1);
        if ((++sp & 255u) == 0u) { if (xb_ld(&bar[XB_TMO])) break; if (sp > XB_SPIN_CAP) { atomicAdd(&bar[XB_TMO], 1u); break; } }
    }
    nloc = mine > 0u ? mine : 1u; nx = cnt > 0u ? cnt : 1u;
}

__device__ __forceinline__ void xcd_barrier(const XcdBarrier& b) {
    asm volatile("s_waitcnt vmcnt(0)" ::: "memory");
    __syncthreads();
    if (threadIdx.x == 0) {
        unsigned* bar = b.bar;
        __builtin_amdgcn_s_waitcnt(0);
        unsigned nloc = b.st[0], nx = b.st[1];
        if (nloc == 0u) { xcd_barrier_complete(bar, b.x, nloc, nx); b.st[0] = nloc; b.st[1] = nx; }
        const unsigned old = xb_add(&bar[XB_XSUB(b.x)], 1u);
        const unsigned gen = old / nloc;
        if (old + 1u == (gen + 1u) * nloc) {
            __builtin_amdgcn_fence(__ATOMIC_RELEASE, "agent");
            asm volatile("s_waitcnt vmcnt(0)" ::: "memory");
            const unsigned og = xb_add(&bar[XB_TOP], 1u);
            const unsigned tg = og / nx;
            if (og + 1u == (tg + 1u) * nx) xb_add(&bar[XB_TOPGEN], 1u);
            else XB_SPIN(xb_ld(&bar[XB_TOPGEN]) == tg, bar);
            __builtin_amdgcn_fence(__ATOMIC_ACQUIRE, "agent");
            xb_add(&bar[XB_XGEN(b.x)], 1u);
            asm volatile("s_waitcnt vmcnt(0)" ::: "memory");
        } else {
            XB_SPIN(xb_ld(&bar[XB_XGEN(b.x)]) == gen, bar);
            __builtin_amdgcn_fence(__ATOMIC_ACQUIRE, "agent");
            asm volatile("s_waitcnt vmcnt(0)" ::: "memory");
        }
    }
    __syncthreads();
}


struct Args { const float* in[18]; float* out; unsigned char* ws; int ph_lo, ph_hi; };

struct Frame {
    LAS unsigned char* lds;
    volatile LAS unsigned* MISC;
    gu32* ctl;
    int tid, lane, wave, G, vcu;
};

__device__ __forceinline__ float wave_sum(float v) {
#pragma unroll
    for (int o = 1; o < 64; o <<= 1) v += __shfl_xor(v, o);
    return v;
}
__device__ __forceinline__ float wave_max(float v) {
#pragma unroll
    for (int o = 1; o < 64; o <<= 1) v = fmaxf(v, __shfl_xor(v, o));
    return v;
}
__device__ __forceinline__ float bf2f(unsigned short u) { return __builtin_bit_cast(float, (unsigned)u << 16); }

__device__ __forceinline__ void p0_transpose_item(const float* W, int K, int N, bf16* WT, int row_off, LAS float* scr, int item, int lane) {
    const int nblk = N / 32, kb = item / nblk, nb = item % nblk, k0 = 64 * kb, n0 = 32 * nb;
#pragma unroll 8
    for (int i = 0; i < 32; ++i) { const int kk = 2 * i + (lane >> 5); scr[kk * 33 + (lane & 31)] = W[(size_t)(k0 + kk) * N + n0 + (lane & 31)]; }
    LDS_WAIT(); asm volatile("" ::: "memory");
    const int c = lane & 7;
#pragma unroll
    for (int j = 0; j < 4; ++j) { const int n = (lane >> 3) + 8 * j; const LAS float* s = scr + (8 * c) * 33 + n;
        v4u o; o.x = pk2(s[0 * 33], s[1 * 33]); o.y = pk2(s[2 * 33], s[3 * 33]); o.z = pk2(s[4 * 33], s[5 * 33]); o.w = pk2(s[6 * 33], s[7 * 33]);
        *(GAS v4u*)(WT + (size_t)(row_off + n0 + n) * K + k0 + 8 * c) = o; }
    LDS_WAIT(); asm volatile("" ::: "memory");
}

__device__ __forceinline__ void ph_convert(const Args& a, Frame& F, int L) {
    LAS float* scr = (LAS float*)(F.lds + RING_OFF + F.wave * 16384);
    const int gw = F.vcu * NWAVES + F.wave, NGW = F.G * NWAVES;
    const int j = L >> 1;
    const float* wqkv = ((L & 1) ? a.in[5] : a.in[1]) + (size_t)j * D * NQKV;
    const float* wo = ((L & 1) ? a.in[8] : a.in[2]) + (size_t)j * D * D;
    const float* win = a.in[10] + (size_t)L * D * FF2;
    const float* wout = a.in[14] + (size_t)L * FF * D;
    bf16* WQKV = (bf16*)(a.ws + WS_WQKV); bf16* WO = (bf16*)(a.ws + WS_WO); bf16* WIN = (bf16*)(a.ws + WS_WIN); bf16* WOUT = (bf16*)(a.ws + WS_WOUT);
    constexpr int I_QKV = (D / 64) * (NQKV / 32), I_O = (D / 64) * (D / 32), I_IN = (D / 64) * (FF2 / 32), I_OUT = (FF / 64) * (D / 32);
    constexpr int NITEMS = I_QKV + I_O + I_IN + I_OUT;
    for (int it = gw; it < NITEMS; it += NGW) {
        int r = it;
        if (r < I_QKV) { p0_transpose_item(wqkv, D, NQKV, WQKV, 0, scr, r, F.lane); continue; } r -= I_QKV;
        if (r < I_O) { p0_transpose_item(wo, D, D, WO, 0, scr, r, F.lane); continue; } r -= I_O;
        if (r < I_IN) { p0_transpose_item(win, D, FF2, WIN, 0, scr, r, F.lane); continue; } r -= I_IN;
        p0_transpose_item(wout, FF, D, WOUT, 0, scr, r, F.lane);
    }
    if (L == 0) {
        bf16* XB = (bf16*)(a.ws + WS_XB);
        for (int m = gw; m < M; m += NGW) {
            const GAS f32x4* xr = (const GAS f32x4*)(a.in[0] + (size_t)m * D) + F.lane;
            GAS unsigned long long* o8 = (GAS unsigned long long*)(XB + (size_t)m * D) + F.lane;
#pragma unroll
            for (int q = 0; q < 4; ++q) { const f32x4 v = xr[64 * q]; o8[64 * q] = (unsigned long long)pk2(v.x, v.y) | ((unsigned long long)pk2(v.z, v.w) << 32); }
        }
    }
}

__device__ __forceinline__ void ph_ln(const Args& a, Frame& F, int L, int which) {
    const int gw = F.vcu * NWAVES + F.wave, NGW = F.G * NWAVES;
    const float* xin = (L == 0 && which == 0) ? a.in[0] : a.out;
    const float* Y = (const float*)(a.ws + WS_Y);
    const float* g = a.in[16] + (size_t)(L * 2 + which) * D; const float* bb = a.in[17] + (size_t)(L * 2 + which) * D;
    bf16* XB = (bf16*)(a.ws + WS_XB);
    f32x4 gv[4], bv[4];
#pragma unroll
    for (int q = 0; q < 4; ++q) { gv[q] = ((const GAS f32x4*)g)[F.lane + 64 * q]; bv[q] = ((const GAS f32x4*)bb)[F.lane + 64 * q]; }
    for (int m = gw; m < M; m += NGW) {
        const GAS f32x4* xr = (const GAS f32x4*)(xin + (size_t)m * D) + F.lane;
        const GAS f32x4* yr = (const GAS f32x4*)(Y + (size_t)m * D) + F.lane;
        f32x4 v[4]; float s = 0.f;
#pragma unroll
        for (int q = 0; q < 4; ++q) { v[q] = xr[64 * q] * ALPHA + yr[64 * q]; s += (v[q].x + v[q].y) + (v[q].z + v[q].w); }
        const float mean = wave_sum(s) * (1.f / D); float s2 = 0.f;
#pragma unroll
        for (int q = 0; q < 4; ++q) { v[q] = v[q] - mean; s2 += (v[q].x * v[q].x + v[q].y * v[q].y) + (v[q].z * v[q].z + v[q].w * v[q].w); }
        const float rstd = 1.f / sqrtf(wave_sum(s2) * (1.f / D) + LN_EPS);
        GAS f32x4* orow = (GAS f32x4*)(a.out + (size_t)m * D) + F.lane;
        GAS unsigned long long* o8 = (GAS unsigned long long*)(XB + (size_t)m * D) + F.lane;
#pragma unroll
        for (int q = 0; q < 4; ++q) { const f32x4 o = v[q] * rstd * gv[q] + bv[q]; orow[64 * q] = o;
            o8[64 * q] = (unsigned long long)pk2(o.x, o.y) | ((unsigned long long)pk2(o.z, o.w) << 32); }
    }
}

__device__ __forceinline__ void ph_conv(const Args& a, Frame& F, int L) {
    const bf16* H = (const bf16*)(a.ws + WS_H); bf16* ACT = (bf16*)(a.ws + WS_ACT);
    const float* cw = a.in[12] + (size_t)L * 3 * FF2; const float* cb = a.in[13] + (size_t)L * FF2;
    constexpr int CPR = FF / 8;
    const long total = (long)M * CPR, nthr = (long)F.G * NWAVES * 64;
    for (long idx = (long)F.vcu * NWAVES * 64 + F.tid; idx < total; idx += nthr) {
        const int row = (int)(idx / CPR), ch = (int)(idx % CPR), col = ch * 8, t = row % SEQ;
        float uo[8], go[8];
#pragma unroll
        for (int e = 0; e < 8; ++e) { uo[e] = cb[col + e]; go[e] = cb[FF + col + e]; }
#pragma unroll
        for (int k = 0; k < 3; ++k) {
            const int tt = t + k - 1; if (tt < 0 || tt >= SEQ) continue;
            const bf16* hp = H + (size_t)(row + k - 1) * FF2 + col;
            const bf16x8 hu = *(const bf16x8*)hp, hg = *(const bf16x8*)(hp + FF);
#pragma unroll
            for (int e = 0; e < 8; ++e) { uo[e] += cw[(size_t)k * FF2 + col + e] * bf2f((unsigned short)hu[e]); go[e] += cw[(size_t)k * FF2 + FF + col + e] * bf2f((unsigned short)hg[e]); }
        }
        v4u o; float r[8];
#pragma unroll
        for (int e = 0; e < 8; ++e) r[e] = uo[e] * (0.5f * go[e] * (1.0f + erff(go[e] * 0.70710678118654752f)));
        o.x = pk2(r[0], r[1]); o.y = pk2(r[2], r[3]); o.z = pk2(r[4], r[5]); o.w = pk2(r[6], r[7]);
        *(GAS v4u*)(ACT + (size_t)row * FF + col) = o;
    }
}

__device__ __forceinline__ void diff_scores(const bf16* kp, const LAS float* qs, float& s1, float& s2) {
    s1 = 0.f; s2 = 0.f;
    asm volatile("" ::: "memory");
#pragma unroll 4
    for (int c = 0; c < 16; ++c) {
        asm volatile("" ::: "memory");
        const bf16x8 kv = *(const bf16x8*)(kp + c * 8);
        const f32x4 q0 = *(const LAS f32x4*)(qs + c * 8), q1 = *(const LAS f32x4*)(qs + c * 8 + 4);
        float acc = q0.x * bf2f((unsigned short)kv[0]) + q0.y * bf2f((unsigned short)kv[1]) + q0.z * bf2f((unsigned short)kv[2]) + q0.w * bf2f((unsigned short)kv[3])
                  + q1.x * bf2f((unsigned short)kv[4]) + q1.y * bf2f((unsigned short)kv[5]) + q1.z * bf2f((unsigned short)kv[6]) + q1.w * bf2f((unsigned short)kv[7]);
        if (c < 8) s1 += acc; else s2 += acc;
    }
}
__device__ __forceinline__ void naive_diff_attn(const Args& a, Frame& F, int L) {
    const int gw = F.vcu * NWAVES + F.wave, NGW = F.G * NWAVES, lane = F.lane;
    const int j = L >> 1;
    const float lam_init = (L == 0) ? 0.2f : 0.47071301834358416f;
    const float* lf = a.in[3] + (size_t)j * 4 * 64;
    const float lam = expf(wave_sum(lf[lane] * lf[64 + lane])) - expf(wave_sum(lf[128 + lane] * lf[192 + lane])) + lam_init;
    const float* sg = a.in[4] + (size_t)j * 128;
    const float g0 = sg[lane], g1 = sg[64 + lane];
    const bf16* Q = (const bf16*)(a.ws + WS_Q); const bf16* K = (const bf16*)(a.ws + WS_K); const bf16* V = (const bf16*)(a.ws + WS_V); bf16* O = (bf16*)(a.ws + WS_O);
    LAS float* qs = (LAS float*)(F.lds + RING_OFF) + F.wave * 128;
    for (int task = gw; task < M * 8; task += NGW) {
        const int h = task & 7, row = task >> 3, b = row / SEQ, t = row % SEQ;
        const bf16* qp = Q + (size_t)row * D + h * 128;
        qs[lane] = bf2f(qp[lane]); qs[64 + lane] = bf2f(qp[64 + lane]);
        LDS_WAIT(); asm volatile("" ::: "memory");
        const float c2 = exp2f(-(float)(h + 1)) * LOG2E;
        const bf16* Kb = K + (size_t)b * SEQ * D + h * 128; const bf16* Vb = V + (size_t)b * SEQ * D + h * 128;
        float m1 = -1e30f, l1 = 0.f, m2 = -1e30f, l2 = 0.f;
        for (int tile = 0; tile < SEQ / 64; ++tile) {
            const int s = tile * 64 + lane; float s1, s2; diff_scores(Kb + (size_t)s * D, qs, s1, s2);
            const float pen = c2 * fabsf((float)(t - s)); s1 -= pen; s2 -= pen;
            float mn = fmaxf(m1, s1); l1 = l1 * exp2f(m1 - mn) + exp2f(s1 - mn); m1 = mn;
            mn = fmaxf(m2, s2); l2 = l2 * exp2f(m2 - mn) + exp2f(s2 - mn); m2 = mn;
        }
        const float M1 = wave_max(m1), M2 = wave_max(m2);
        const float i1 = 1.f / wave_sum(l1 * exp2f(m1 - M1)), i2 = lam / wave_sum(l2 * exp2f(m2 - M2));
        float o0 = 0.f, o1 = 0.f;
        for (int tile = 0; tile < SEQ / 64; ++tile) {
            const int s = tile * 64 + lane; float s1, s2; diff_scores(Kb + (size_t)s * D, qs, s1, s2);
            const float pen = c2 * fabsf((float)(t - s)); s1 -= pen; s2 -= pen;
            const float av = exp2f(s1 - M1) * i1 - exp2f(s2 - M2) * i2;
            const bf16* vp = Vb + (size_t)(tile * 64) * D + lane;
#pragma unroll 8
            for (int jj = 0; jj < 64; ++jj) { const float aj = __shfl(av, jj); o0 += aj * bf2f(vp[(size_t)jj * D]); o1 += aj * bf2f(vp[(size_t)jj * D + 64]); }
        }
        const float ms = wave_sum(o0 * o0 + o1 * o1) * (1.f / 128.f);
        const float r = (1.f / sqrtf(ms + RMS_EPS)) * (1.f - lam_init);
        bf16* op = O + (size_t)row * D + h * 128;
        op[lane] = (bf16)f2bf(o0 * r * g0); op[64 + lane] = (bf16)f2bf(o1 * r * g1);
        asm volatile("" ::: "memory");
    }
}

namespace da {
typedef short bf16x8 __attribute__((ext_vector_type(8)));
typedef short s16x4 __attribute__((ext_vector_type(4)));
typedef float f32x16 __attribute__((ext_vector_type(16)));
typedef float f32x4v __attribute__((ext_vector_type(4)));
typedef unsigned u32x2v __attribute__((ext_vector_type(2)));
constexpr int SLOT = 32768, EXS = 129;
constexpr float THR = 6.0f;
__device__ __forceinline__ s16x4 vtr(const LAS unsigned char* p) { return __builtin_bit_cast(s16x4, __builtin_amdgcn_ds_read_tr16_b64_v4i16((LAS s16x4*)p)); }
__device__ __forceinline__ unsigned cvtpk(float lo, float hi) { typedef float f2 __attribute__((ext_vector_type(2))); typedef __bf16 b2 __attribute__((ext_vector_type(2))); f2 v = {lo, hi}; b2 b = __builtin_convertvector(v, b2); return __builtin_bit_cast(unsigned, b); }
__device__ __forceinline__ bf16x8 pack8(const f32x16& p, int base) {
    typedef unsigned u4 __attribute__((ext_vector_type(4)));
    u4 w; w.x = cvtpk(p[base], p[base + 1]); w.y = cvtpk(p[base + 2], p[base + 3]); w.z = cvtpk(p[base + 4], p[base + 5]); w.w = cvtpk(p[base + 6], p[base + 7]);
    return __builtin_bit_cast(bf16x8, w);
}
__device__ __forceinline__ void issue_tile(const bf16* Kh, const bf16* Vh, int tile, LAS unsigned char* slot, int wave, int lane) {
#pragma unroll
    for (int i = 0; i < 4; ++i) {
        const int p = wave + 8 * i; const bf16* src;
        if (i < 2) src = Kh + (size_t)(tile * 64 + lane) * D + i * 64 + wave * 8;
        else { const int pv = p - 16, db = pv >> 2, kg = pv & 3; src = Vh + (size_t)(tile * 64 + 16 * kg + (lane >> 2)) * D + 32 * db + (lane & 3) * 8; }
        __builtin_amdgcn_global_load_lds((const unsigned*)src, (LAS unsigned*)(slot + p * 1024), 16, 0, 0);
    }
}
__device__ __forceinline__ void unit(int b, int h, int qblk, const bf16* Q, const bf16* K, const bf16* V, bf16* O, LAS unsigned char* ring, float lam, float one_m_li, const float* sg, int wave, int lane) {
    const int r32 = lane & 31, hi = lane >> 5, c = wave >> 2, qs = wave & 3;
    const size_t rowbase = (size_t)b * SEQ; const int q0 = qblk * 128 + 32 * qs;
    const bf16* Kh = K + rowbase * D + h * 128; const bf16* Vh = V + rowbase * D + h * 128;
    issue_tile(Kh, Vh, 0, ring, wave, lane);
    const bf16* Qw = Q + (rowbase + q0 + r32) * D + h * 128 + c * 64 + hi * 8;
    bf16x8 qr[4];
#pragma unroll
    for (int d0 = 0; d0 < 4; ++d0) qr[d0] = *(const bf16x8*)(Qw + d0 * 16);
    f32x16 o[4];
#pragma unroll
    for (int db = 0; db < 4; ++db)
#pragma unroll
        for (int r = 0; r < 16; ++r) o[db][r] = 0.f;
    float m = -1e30f, l = 0.f;
    const float c2 = exp2f(-(float)(h + 1)) * LOG2E;
    const float qpos = (float)(q0 + r32 - 4 * hi);
    for (int i = 0; i < SEQ / 64; ++i) {
        asm volatile("s_waitcnt vmcnt(0)" ::: "memory"); __syncthreads();
        if (i + 1 < SEQ / 64) issue_tile(Kh, Vh, i + 1, ring + ((i + 1) & 1) * SLOT, wave, lane);
        const LAS unsigned char* slot = ring + (i & 1) * SLOT;
        const LAS unsigned char* kb = slot + c * 8192 + hi * 1024 + r32 * 16;
        f32x16 p0, p1;
#pragma unroll
        for (int r = 0; r < 16; ++r) { p0[r] = 0.f; p1[r] = 0.f; }
#pragma unroll
        for (int d0 = 0; d0 < 4; ++d0) {
            const bf16x8 b0 = *(const LAS bf16x8*)(kb + d0 * 2048), b1 = *(const LAS bf16x8*)(kb + d0 * 2048 + 512);
            p0 = __builtin_amdgcn_mfma_f32_32x32x16_bf16(b0, qr[d0], p0, 0, 0, 0);
            p1 = __builtin_amdgcn_mfma_f32_32x32x16_bf16(b1, qr[d0], p1, 0, 0, 0);
        }
        const float dq = qpos - (float)(64 * i);
        float rm = -1e30f;
#pragma unroll
        for (int r = 0; r < 16; ++r) { const float kc = (float)((r & 3) + 8 * (r >> 2));
            p0[r] = __builtin_fmaf(-c2, __builtin_fabsf(dq - kc), p0[r]); p1[r] = __builtin_fmaf(-c2, __builtin_fabsf(dq - kc - 32.f), p1[r]);
            rm = __builtin_fmaxf(rm, __builtin_fmaxf(p0[r], p1[r])); }
        rm = __builtin_fmaxf(rm, __shfl_xor(rm, 32));
        const bool grow = rm > m + THR;
        if (__any(grow)) {
            const float mn = grow ? rm : m; const float al = __builtin_amdgcn_exp2f(m - mn); l *= al; m = mn;
#pragma unroll
            for (int db = 0; db < 4; ++db)
#pragma unroll
                for (int r = 0; r < 16; ++r) o[db][r] *= al;
        }
        float ps = 0.f;
#pragma unroll
        for (int r = 0; r < 16; ++r) { p0[r] = __builtin_amdgcn_exp2f(p0[r] - m); p1[r] = __builtin_amdgcn_exp2f(p1[r] - m); ps += p0[r] + p1[r]; }
        l += ps;
        bf16x8 pb[4]; pb[0] = pack8(p0, 0); pb[1] = pack8(p0, 8); pb[2] = pack8(p1, 0); pb[3] = pack8(p1, 8);
        const LAS unsigned char* vb = slot + 16384 + (4 * hi + ((lane & 15) >> 2)) * 64 + ((lane >> 4) & 1) * 32 + (lane & 3) * 8;
#pragma unroll
        for (int db = 0; db < 4; ++db)
#pragma unroll
            for (int ks = 0; ks < 4; ++ks) {
                const s16x4 lo = vtr(vb + db * 4096 + ks * 1024), hh = vtr(vb + db * 4096 + ks * 1024 + 512);
                const bf16x8 vf = (bf16x8){lo[0], lo[1], lo[2], lo[3], hh[0], hh[1], hh[2], hh[3]};
                o[db] = __builtin_amdgcn_mfma_f32_32x32x16_bf16(vf, pb[ks], o[db], 0, 0, 0);
            }
    }
    l += __shfl_xor(l, 32); const float inv = 1.f / l;
    __syncthreads();
    LAS float* ex = (LAS float*)ring + (qs * 32 + r32) * EXS;
    if (c == 1) { const float f = inv * lam;
#pragma unroll
        for (int db = 0; db < 4; ++db)
#pragma unroll
            for (int r = 0; r < 16; ++r) ex[32 * db + (r & 3) + 8 * (r >> 2) + 4 * hi] = o[db][r] * f; }
    __syncthreads();
    if (c == 0) {
        float ss = 0.f;
#pragma unroll
        for (int db = 0; db < 4; ++db)
#pragma unroll
            for (int r = 0; r < 16; ++r) { const float v = o[db][r] * inv - ex[32 * db + (r & 3) + 8 * (r >> 2) + 4 * hi]; o[db][r] = v; ss += v * v; }
        ss += __shfl_xor(ss, 32);
        const float rn = (1.f / sqrtf(ss * (1.f / 128.f) + RMS_EPS)) * one_m_li;
        bf16* orow = O + (rowbase + q0 + r32) * D + h * 128;
#pragma unroll
        for (int db = 0; db < 4; ++db)
#pragma unroll
            for (int g4 = 0; g4 < 4; ++g4) { const int d = 32 * db + 8 * g4 + 4 * hi; const f32x4v gg = *(const f32x4v*)(sg + d);
                u32x2v w; w.x = cvtpk(o[db][4 * g4] * rn * gg.x, o[db][4 * g4 + 1] * rn * gg.y); w.y = cvtpk(o[db][4 * g4 + 2] * rn * gg.z, o[db][4 * g4 + 3] * rn * gg.w);
                *(u32x2v*)(orow + d) = w; }
    }
    __syncthreads();
}
}
__device__ __forceinline__ void ph_diff_attn(const Args& a, Frame& F, int L) {
    const int j = L >> 1, lane = F.lane;
    const float lam_init = (L == 0) ? 0.2f : 0.47071301834358416f;
    const float* lf = a.in[3] + (size_t)j * 4 * 64;
    const float lam = expf(wave_sum(lf[lane] * lf[64 + lane])) - expf(wave_sum(lf[128 + lane] * lf[192 + lane])) + lam_init;
    const float* sg = a.in[4] + (size_t)j * 128;
    const bf16* Q = (const bf16*)(a.ws + WS_Q); const bf16* K = (const bf16*)(a.ws + WS_K); const bf16* V = (const bf16*)(a.ws + WS_V); bf16* O = (bf16*)(a.ws + WS_O);
    for (int u = F.vcu; u < BATCH * 8 * (SEQ / 128); u += F.G) {
        const int bh = u >> 5, qblk = u & 31;
        da::unit(bh >> 3, bh & 7, qblk, Q, K, V, O, F.lds + RING_OFF, lam, 1.f - lam_init, sg, F.wave, lane);
    }
}

__device__ __forceinline__ void naive_na_attn(const Args& a, Frame& F, int L) {
    const int gw = F.vcu * NWAVES + F.wave, NGW = F.G * NWAVES, lane = F.lane;
    const int j = L >> 1;
    const float* rpb = a.in[7] + (size_t)j * 16 * 15 * 31;
    const bf16* Q = (const bf16*)(a.ws + WS_Q); const bf16* K = (const bf16*)(a.ws + WS_K); const bf16* V = (const bf16*)(a.ws + WS_V); bf16* O = (bf16*)(a.ws + WS_O);
    LAS float* qs = (LAS float*)(F.lds + RING_OFF) + F.wave * 128;
    for (int task = gw; task < M * 16; task += NGW) {
        const int h = task & 15, row = task >> 4, b = row / SEQ, t = row % SEQ, r = t >> 6, c = t & 63;
        const int rs = min(max(r - 4, 0), 56), cs = min(max(c - 8, 0), 48);
        qs[lane] = bf2f(Q[(size_t)row * D + h * 64 + lane]);
        LDS_WAIT(); asm volatile("" ::: "memory");
        const bf16* Kb = K + (size_t)b * SEQ * D + h * 64; const bf16* Vb = V + (size_t)b * SEQ * D + h * 64;
        float sc[2];
#pragma unroll
        for (int hf = 0; hf < 2; ++hf) {
            const int kk = lane + 64 * hf, i = kk >> 4, jj = kk & 15, kt = (rs + i) * 64 + cs + jj;
            const bf16* kp = Kb + (size_t)kt * D; float acc = 0.f;
#pragma unroll
            for (int cc = 0; cc < 8; ++cc) { const bf16x8 kv = *(const bf16x8*)(kp + cc * 8);
#pragma unroll
                for (int e = 0; e < 8; ++e) acc += qs[cc * 8 + e] * bf2f((unsigned short)kv[e]); }
            sc[hf] = acc + rpb[((size_t)h * 15 + (rs + i - r + 7)) * 31 + (cs + jj - c + 15)] * LOG2E;
        }
        const float mx = wave_max(fmaxf(sc[0], sc[1]));
        const float p0 = exp2f(sc[0] - mx), p1 = exp2f(sc[1] - mx);
        const float inv = 1.f / wave_sum(p0 + p1);
        float o = 0.f;
#pragma unroll 8
        for (int kk = 0; kk < 128; ++kk) { const int i = kk >> 4, jj = kk & 15, kt = (rs + i) * 64 + cs + jj;
            const float pk = __shfl(kk < 64 ? p0 : p1, kk & 63); o += pk * bf2f(Vb[(size_t)kt * D + lane]); }
        O[(size_t)row * D + h * 64 + lane] = (bf16)f2bf(o * inv);
        asm volatile("" ::: "memory");
    }
}

template <int S> __device__ __forceinline__ void run_phase(const Args& args, Frame& F0, int L) {
    Frame F = F0; { int t_ = threadIdx.x; asm volatile("" : "+v"(t_)); F.tid = t_; F.lane = t_ & 63; F.wave = __builtin_amdgcn_readfirstlane(t_ >> 6); }
    const int j = L >> 1; const bool na = (L & 1) != 0;
    bf16* WQKV = (bf16*)(args.ws + WS_WQKV); bf16* WO = (bf16*)(args.ws + WS_WO); bf16* WIN = (bf16*)(args.ws + WS_WIN); bf16* WOUT = (bf16*)(args.ws + WS_WOUT);
    bf16* XB = (bf16*)(args.ws + WS_XB); bf16* ACT = (bf16*)(args.ws + WS_ACT); bf16* HB = (bf16*)(args.ws + WS_H);
    bf16* QB = (bf16*)(args.ws + WS_Q); bf16* OB = (bf16*)(args.ws + WS_O); float* Y = (float*)(args.ws + WS_Y);
    if constexpr (S == 0) ph_convert(args, F, L);
    else if constexpr (S == 1) {
        pg8::Gemm g{XB, WQKV, M, NQKV, D}; pg8::StaticOrder So; So.init(M, NQKV, F.G, (int)blockIdx.x);
        pg8::EpiBf16<0> E{QB, D, na ? args.in[6] + (size_t)j * NQKV : nullptr, D, (size_t)(WS_K - WS_Q) / 2, QSCALE};
        pg8::gemm_phase<pg8::EpiBf16<0>, pg8::StaticOrder, PG8_ALIGN, PG8_SP2>(F.lds + RING_OFF, g, So, E);
    }
    else if constexpr (S == 2) { if (na) naive_na_attn(args, F, L); else {
#if NAIVE_DIFF
        naive_diff_attn(args, F, L);
#else
        ph_diff_attn(args, F, L);
#endif
    } }
    else if constexpr (S == 3) {
        pg8::Gemm g{OB, WO, M, D, D}; pg8::StaticOrder So; So.init(M, D, F.G, (int)blockIdx.x);
        pg8::EpiF32 E{Y, D, na ? args.in[9] + (size_t)j * D : nullptr};
        pg8::gemm_phase<pg8::EpiF32, pg8::StaticOrder, PG8_ALIGN, PG8_SP2>(F.lds + RING_OFF, g, So, E);
    }
    else if constexpr (S == 4) ph_ln(args, F, L, 0);
    else if constexpr (S == 5) {
        pg8::Gemm g{XB, WIN, M, FF2, D}; pg8::StaticOrder So; So.init(M, FF2, F.G, (int)blockIdx.x);
        pg8::EpiBf16<0> E{HB, FF2, args.in[11] + (size_t)L * FF2, 0, 0, 1.f};
        pg8::gemm_phase<pg8::EpiBf16<0>, pg8::StaticOrder, PG8_ALIGN, PG8_SP2>(F.lds + RING_OFF, g, So, E);
    }
    else if constexpr (S == 6) ph_conv(args, F, L);
    else if constexpr (S == 7) {
        pg8::Gemm g{ACT, WOUT, M, D, FF}; pg8::StaticOrder So; So.init(M, D, F.G, (int)blockIdx.x);
        pg8::EpiF32 E{Y, D, args.in[15] + (size_t)L * D};
        pg8::gemm_phase<pg8::EpiF32, pg8::StaticOrder, PG8_ALIGN, PG8_SP2>(F.lds + RING_OFF, g, So, E);
    }
    else ph_ln(args, F, L, 1);
}
__device__ __forceinline__ void frame_init(Frame& F, const Args& args, unsigned char* lds) {
    F.lds = (LAS unsigned char*)lds;
    F.MISC = (volatile LAS unsigned*)(F.lds + MISC_OFF);
    F.tid = threadIdx.x; F.lane = F.tid & 63; F.wave = __builtin_amdgcn_readfirstlane(F.tid >> 6);
    F.G = gridDim.x; { const int bx = blockIdx.x; F.vcu = (F.G % 8 == 0) ? (bx % 8) * (F.G / 8) + bx / 8 : bx; }
    F.ctl = (gu32*)(args.ws + WS_CTL);
}
template <int S> __global__ void __launch_bounds__(NWAVES * 64, 2) phase_kernel(Args args) {
    extern __shared__ __attribute__((aligned(16))) unsigned char lds[];
    Frame F; frame_init(F, args, lds);
    run_phase<S>(args, F, args.ph_lo);
}

__global__ void __launch_bounds__(NWAVES * 64, 2) fwd_kernel(Args args) {
    extern __shared__ __attribute__((aligned(16))) unsigned char lds[];
    Frame F; frame_init(F, args, lds);
    for (int u = F.tid; u < (LDS_BYTES - LDSCTL_OFF) / 4; u += NWAVES * 64) ((LAS unsigned*)(F.lds + LDSCTL_OFF))[u] = 0u;
    __syncthreads();
    XcdBarrier bar = xcd_barrier_post((unsigned*)(F.ctl + CW_BAR), F.MISC + 8);
    const int lo = args.ph_lo, hi = args.ph_hi;
    for (int p = lo; p < hi; ++p) {
        const int L = p / PH_PER_LAYER, s = p % PH_PER_LAYER;
        switch (s) {
            case 0: run_phase<0>(args, F, L); break;
            case 1: run_phase<1>(args, F, L); break;
            case 2: run_phase<2>(args, F, L); break;
            case 3: run_phase<3>(args, F, L); break;
            case 4: run_phase<4>(args, F, L); break;
            case 5: run_phase<5>(args, F, L); break;
            case 6: run_phase<6>(args, F, L); break;
            case 7: run_phase<7>(args, F, L); break;
            default: run_phase<8>(args, F, L); break;
        }
        if (p + 1 < hi) xcd_barrier(bar);
    }
}

template <int S> static void launch_phase(int grid, Args a, int L, hipStream_t stream) {
    static bool attr = false;
    if (!attr) { (void)hipFuncSetAttribute((const void*)phase_kernel<S>, hipFuncAttributeMaxDynamicSharedMemorySize, LDS_BYTES); attr = true; }
    a.ph_lo = L; a.ph_hi = S;
    hipLaunchKernelGGL(phase_kernel<S>, dim3(grid), dim3(NWAVES * 64), LDS_BYTES, stream, a);
}
extern "C" void kernel_launch(void* const* d_in, const int* in_sizes, int n_in, void* d_out, int out_size, void* d_ws, size_t ws_size, hipStream_t stream) {
    static int grid = 0;
    if (grid == 0) {
        if (n_in != 18 || in_sizes[0] != M * D || out_size != M * D || ws_size < WS_END) { fprintf(stderr, "kernel_launch: unexpected shapes (n_in %d, in0 %d, out %d, ws %zu)\n", n_in, n_in > 0 ? in_sizes[0] : -1, out_size, ws_size); grid = -1; return; }
        int dev = 0, cus = 0;
        if (hipGetDevice(&dev) != hipSuccess || hipDeviceGetAttribute(&cus, hipDeviceAttributeMultiprocessorCount, dev) != hipSuccess) { grid = -1; return; }
        grid = cus;
    }
    if (grid < 0) return;
    (void)hipMemsetAsync((char*)d_ws + WS_CTL, 0, CTL_ZERO_BYTES, stream);
    Args a{};
    for (int i = 0; i < 18; ++i) a.in[i] = (const float*)d_in[i];
    a.out = (float*)d_out; a.ws = (unsigned char*)d_ws;
#if MK_ONE_LAUNCH
    static bool attr1 = false;
    if (!attr1) { (void)hipFuncSetAttribute((const void*)fwd_kernel, hipFuncAttributeMaxDynamicSharedMemorySize, LDS_BYTES); attr1 = true; }
    a.ph_lo = 0; a.ph_hi = N_PHASES;
    hipLaunchKernelGGL(fwd_kernel, dim3(grid), dim3(NWAVES * 64), LDS_BYTES, stream, a);
#else
    for (int L = 0; L < DEPTH; ++L) {
        launch_phase<0>(grid, a, L, stream); launch_phase<1>(grid, a, L, stream); launch_phase<2>(grid, a, L, stream);
        launch_phase<3>(grid, a, L, stream); launch_phase<4>(grid, a, L, stream); launch_phase<5>(grid, a, L, stream);
        launch_phase<6>(grid, a, L, stream); launch_phase<7>(grid, a, L, stream); launch_phase<8>(grid, a, L, stream);
    }
#endif
}
```

```cpp
#include <hip/hip_runtime.h>
#include <cstdio>
#include <cstdint>
namespace pg8 {
#define PG8_LAS __attribute__((address_space(3)))
typedef unsigned short bf16_t;
typedef short bf16x8 __attribute__((ext_vector_type(8)));
typedef float f32x4 __attribute__((ext_vector_type(4)));
typedef unsigned u32x4 __attribute__((ext_vector_type(4)));
constexpr int BM = 256, BK = 64, HALF = 128, HTB = HALF * BK * 2  , STAGE_BYTES = 8 * HTB, NXCD = 8, WGM = 8;

__host__ __device__ __forceinline__ int lds_byte(int r, int c) { const int st = (r >> 4) * 2 + (c >> 5), rr = r & 15, cc = c & 31, ob = rr * 64 + cc * 2; return st * 1024 + (ob ^ (((ob >> 9) & 1) << 5)); }
__host__ __device__ __forceinline__ void stage_rc(int b, int& R, int& C) { const int st = b / 1024, sb = b % 1024, swz = sb ^ (((sb >> 9) & 1) << 5); R = (st >> 1) * 16 + swz / 64; C = (st & 1) * 32 + (swz % 64) / 2; }
__host__ __device__ __forceinline__ int perm32(int rho) { const int n = rho >> 4, i = rho & 15; return 8 * (i >> 2) + 4 * n + (i & 3); }

struct Unit { int pm, pn; };
struct Gemm { const bf16_t* A; const bf16_t* Bt; int M, N, K; };

struct StaticOrder {
    int nM, nN, nwg, G, c;
    __host__ __device__ void init(int M, int N, int G_, int c_) { nM = M / BM; nN = N / BM; nwg = nM * nN; G = G_; c = c_; }
    __host__ __device__ bool next(int i, Unit& u) const {
        const long L = (long)i * G + c; if (L >= nwg) return false;
        int wgid = (int)L; { const int q = nwg / NXCD, r = nwg % NXCD, xcd = wgid % NXCD, off = wgid / NXCD; wgid = (xcd < r ? xcd * (q + 1) : r * (q + 1) + (xcd - r) * q) + off; }
        const int nig = WGM * nN, gid = wgid / nig, fm = gid * WGM, gsz = (nM - fm) < WGM ? (nM - fm) : WGM;
        u.pm = fm + ((wgid % nig) % gsz); u.pn = (wgid % nig) / gsz; return true;
    }
    __device__ __forceinline__ void a_ready(const Unit&) const {}
    __device__ __forceinline__ void done(const Unit&) const {}
};

__device__ __forceinline__ unsigned cvt_pk_bf16(float lo, float hi) { unsigned r; asm volatile("v_cvt_pk_bf16_f32 %0, %1, %2" : "=v"(r) : "v"(lo), "v"(hi)); return r; }
typedef float f32x2 __attribute__((ext_vector_type(2)));
__device__ __forceinline__ f32x2 gelu_pk(f32x2 v) {
    const f32x2 av = __builtin_elementwise_abs(v), d = av * 0.2316418882f + 1.0f;
    f32x2 t; t.x = __builtin_amdgcn_rcpf(d.x); t.y = __builtin_amdgcn_rcpf(d.y);
    f32x2 q = t * 0.5307027145f + (-0.7265760135f); q = q * t + 0.7107068705f; q = q * t + (-0.142248368f); q = q * t + 0.127414796f; q = q * t;
    const f32x2 s = (v * v) * (-0.72134752044f);
    f32x2 e; e.x = __builtin_amdgcn_exp2f(s.x); e.y = __builtin_amdgcn_exp2f(s.y);
    const f32x2 m = v * (q * e), r = v - m;
    f32x2 o; o.x = v.x < 0.f ? m.x : r.x; o.y = v.y < 0.f ? m.y : r.y; return o;
}

template <int ACT  > struct EpiBf16 {
    static constexpr bool PERM = true, AFTER_DRAIN = false; static_assert(ACT == 0 || ACT == 1, "EpiBf16: ACT is 0 (none) or 1 (gelu_pk)");
    bf16_t* O; int ldc; const float* bias; int split_cols; size_t split_stride; float scale0;
    __device__ __forceinline__ void operator()(const f32x4 (&acc)[2][2][4][2], const Unit& u, int wr, int wc, int fr, int fq) const {
        const int row0 = u.pm * BM + wr * 64 + fr; int colt = u.pn * BM; bf16_t* base = O;
        float sc = 1.f; if (split_cols) { const int t = colt / split_cols; base += (size_t)t * split_stride; colt -= t * split_cols; if (t == 0) sc = scale0; }
        const int col0 = colt + wc * 32 + 8 * fq, bcol0 = u.pn * BM + wc * 32 + 8 * fq;
        f32x4 bv[2][2];
#pragma unroll
        for (int bj = 0; bj < 2; ++bj)
#pragma unroll
            for (int n = 0; n < 2; ++n) bv[bj][n] = bias ? *(const f32x4*)(bias + bcol0 + bj * HALF + 4 * n) : (f32x4){0.f, 0.f, 0.f, 0.f};
#pragma unroll
        for (int ai = 0; ai < 2; ++ai)
#pragma unroll
            for (int m = 0; m < 4; ++m) { bf16_t* rowp = base + (size_t)(row0 + ai * HALF + m * 16) * ldc + col0;
#pragma unroll
                for (int bj = 0; bj < 2; ++bj) { f32x4 v0 = acc[ai][bj][m][0] + bv[bj][0], v1 = acc[ai][bj][m][1] + bv[bj][1];
                    if (ACT == 1) { f32x2 a = gelu_pk((f32x2){v0[0], v0[1]}), b = gelu_pk((f32x2){v0[2], v0[3]}), c = gelu_pk((f32x2){v1[0], v1[1]}), d = gelu_pk((f32x2){v1[2], v1[3]});
                        v0 = (f32x4){a.x, a.y, b.x, b.y}; v1 = (f32x4){c.x, c.y, d.x, d.y}; }
                    v0 = v0 * sc; v1 = v1 * sc; u32x4 w; w.x = cvt_pk_bf16(v0[0], v0[1]); w.y = cvt_pk_bf16(v0[2], v0[3]); w.z = cvt_pk_bf16(v1[0], v1[1]); w.w = cvt_pk_bf16(v1[2], v1[3]);
                    *(u32x4*)(rowp + bj * HALF) = w; } }
    }
};
struct EpiF32 {
    static constexpr bool PERM = false, AFTER_DRAIN = false;
    float* C; int ldc; const float* bias;
    __device__ __forceinline__ void operator()(const f32x4 (&acc)[2][2][4][2], const Unit& u, int wr, int wc, int fr, int fq) const {
        const int row0 = u.pm * BM + wr * 64 + fr, col0 = u.pn * BM + wc * 32 + 4 * fq;
        f32x4 bv[2][2];
#pragma unroll
        for (int bj = 0; bj < 2; ++bj)
#pragma unroll
            for (int n = 0; n < 2; ++n) bv[bj][n] = bias ? *(const f32x4*)(bias + col0 + bj * HALF + n * 16) : (f32x4){0.f, 0.f, 0.f, 0.f};
#pragma unroll
        for (int ai = 0; ai < 2; ++ai)
#pragma unroll
            for (int m = 0; m < 4; ++m) { float* rowp = C + (size_t)(row0 + ai * HALF + m * 16) * ldc + col0;
#pragma unroll
                for (int bj = 0; bj < 2; ++bj)
#pragma unroll
                    for (int n = 0; n < 2; ++n) *(f32x4*)(rowp + bj * HALF + n * 16) = acc[ai][bj][m][n] + bv[bj][n]; }
    }
};
template <class Epi, class Sched, bool ALIGN_EPI = false, bool SP2 = false>
__device__ __forceinline__ void gemm_phase(PG8_LAS unsigned char* lds, const Gemm g, const Sched& S, const Epi& E) {
    int tid_ = threadIdx.x; asm volatile("" : "+v"(tid_));
    const int tid = tid_, wid = __builtin_amdgcn_readfirstlane(tid >> 6), lane = tid & 63, wr = wid >> 2, wc = wid & 3, fr = lane & 15, fq = lane >> 4;
    const int K = g.K, nt = K / BK;
    unsigned voffA[2], voffB[2];
#pragma unroll
    for (int i = 0; i < 2; ++i) { int R, C; stage_rc(tid * 16 + i * 8192, R, C); const int Rb = Epi::PERM ? ((R & ~31) + perm32(R & 31)) : R;
        voffA[i] = (unsigned)(R * K + C) * 2u; voffB[i] = (unsigned)(Rb * K + C) * 2u; }
    const size_t kstep = (size_t)(BK * 2);
    const size_t hstep = (size_t)HALF * K * 2;
    const size_t tstep = 2 * hstep;
    const unsigned ldsw = (unsigned)wid * 1024u;
    const int aoff = lds_byte(wr * 64 + fr, fq * 8), boff = lds_byte(wc * 32 + fr, fq * 8);
#define PG8_SA(b, h) (((b) * 2 + (h)) * HTB)
#define PG8_SB(b, h) ((4 + (b) * 2 + (h)) * HTB)
#define PG8_STAGE(bufoff, gbase, voff) do { _Pragma("unroll") for (int _i = 0; _i < 2; ++_i) \
        __builtin_amdgcn_global_load_lds((const unsigned*)((const char*)(gbase) + (voff)[_i]), (PG8_LAS unsigned*)(lds + (bufoff) + ldsw + _i * 8192), 16, 0, 0); } while (0)
#define PG8_LDA(dst, b, h) do { _Pragma("unroll") for (int m = 0; m < 4; ++m) _Pragma("unroll") for (int k = 0; k < 2; ++k) dst[m][k] = *(const PG8_LAS bf16x8*)(lds + PG8_SA(b, h) + aoff + m * 2048 + k * 1024); } while (0)
#define PG8_LDB(dst, b, h) do { _Pragma("unroll") for (int n = 0; n < 2; ++n) _Pragma("unroll") for (int k = 0; k < 2; ++k) dst[n][k] = *(const PG8_LAS bf16x8*)(lds + PG8_SB(b, h) + boff + n * 2048 + k * 1024); } while (0)
#define PG8_MMA(ai, bj, At, Bt) do { __builtin_amdgcn_s_setprio(1); _Pragma("unroll") for (int m = 0; m < 4; ++m) _Pragma("unroll") for (int n = 0; n < 2; ++n) _Pragma("unroll") for (int k = 0; k < 2; ++k) \
        acc[ai][bj][m][n] = __builtin_amdgcn_mfma_f32_16x16x32_bf16(Bt[n][k], At[m][k], acc[ai][bj][m][n], 0, 0, 0); __builtin_amdgcn_s_setprio(0); } while (0)
#define PG8_WAIT_V(n) asm volatile("s_waitcnt vmcnt(" #n ")" ::: "memory")
#define PG8_WAIT_L(n) asm volatile("s_waitcnt lgkmcnt(" #n ")" ::: "memory")
#define PG8_BAR __builtin_amdgcn_s_barrier()
#define PG8_SCHED __builtin_amdgcn_sched_barrier(0)
    Unit cur, nxt; int ui = 0;
    if (!S.next(0, cur)) return;
    f32x4 acc[2][2][4][2];
#pragma unroll
    for (int a = 0; a < 2; ++a)
#pragma unroll
        for (int b = 0; b < 2; ++b)
#pragma unroll
            for (int m = 0; m < 4; ++m)
#pragma unroll
                for (int n = 0; n < 2; ++n) acc[a][b][m][n] = (f32x4){0.f, 0.f, 0.f, 0.f};
    bf16x8 At[4][2], B0[2][2], B1[2][2];
    const char* cA = (const char*)g.A + (size_t)cur.pm * tstep; const char* cB = (const char*)g.Bt + (size_t)cur.pn * tstep;
    S.a_ready(cur);
    if constexpr (SP2) {
        PG8_STAGE(PG8_SB(0, 0), cB, voffB); PG8_STAGE(PG8_SB(0, 1), cB + hstep, voffB); PG8_STAGE(PG8_SA(0, 0), cA, voffA); PG8_STAGE(PG8_SA(0, 1), cA + hstep, voffA);
        if (wr == 1) PG8_BAR;
        PG8_WAIT_V(2); PG8_BAR;
        PG8_STAGE(PG8_SB(1, 0), cB + kstep, voffB); PG8_STAGE(PG8_SA(1, 0), cA + kstep, voffA); PG8_STAGE(PG8_SB(1, 1), cB + hstep + kstep, voffB);
        PG8_WAIT_V(6); PG8_BAR;
    } else {
        PG8_STAGE(PG8_SB(0, 0), cB, voffB); PG8_STAGE(PG8_SA(0, 0), cA, voffA); PG8_STAGE(PG8_SB(0, 1), cB + hstep, voffB); PG8_STAGE(PG8_SA(0, 1), cA + hstep, voffA);
        if (wr == 1) PG8_BAR;
        PG8_WAIT_V(4); PG8_BAR;
        PG8_STAGE(PG8_SB(1, 0), cB + kstep, voffB); PG8_STAGE(PG8_SA(1, 0), cA + kstep, voffA); PG8_STAGE(PG8_SB(1, 1), cB + hstep + kstep, voffB);
        PG8_WAIT_V(6); PG8_BAR;
    }
    for (;;) {
        const bool has_next = S.next(ui + 1, nxt);
        const char* nA = has_next ? (const char*)g.A + (size_t)nxt.pm * tstep : cA; const char* nB = has_next ? (const char*)g.Bt + (size_t)nxt.pn * tstep : cB;
        for (int t = 0; t < nt; t += 2) {
            const bool last = (t == nt - 2);
            const char* a1 = cA + (size_t)(t + 1) * kstep;
            const char* a2 = last ? nA : cA + (size_t)(t + 2) * kstep; const char* b2 = last ? nB : cB + (size_t)(t + 2) * kstep;
            const char* a3 = a2 + kstep; const char* b3 = b2 + kstep;
            if (last && has_next) S.a_ready(nxt);
            if constexpr (SP2) {
            PG8_LDB(B0, 0, 0); PG8_LDB(B1, 0, 1); PG8_SCHED; PG8_LDA(At, 0, 0); PG8_STAGE(PG8_SA(1, 1), a1 + hstep, voffA);
            PG8_WAIT_V(8); PG8_WAIT_L(0); PG8_BAR; PG8_MMA(0, 0, At, B0); PG8_MMA(0, 1, At, B1); PG8_BAR; PG8_SCHED;
            PG8_LDA(At, 0, 1); PG8_STAGE(PG8_SB(0, 0), b2, voffB); PG8_STAGE(PG8_SB(0, 1), b2 + hstep, voffB); PG8_STAGE(PG8_SA(0, 0), a2, voffA);
            PG8_WAIT_V(8); PG8_WAIT_L(0); PG8_BAR; PG8_MMA(1, 0, At, B0); PG8_MMA(1, 1, At, B1); PG8_BAR; PG8_SCHED;
            PG8_LDB(B0, 1, 0); PG8_LDB(B1, 1, 1); PG8_SCHED; PG8_LDA(At, 1, 0); PG8_STAGE(PG8_SA(0, 1), a2 + hstep, voffA);
            PG8_WAIT_V(8); PG8_WAIT_L(0); PG8_BAR; PG8_MMA(0, 0, At, B0); PG8_MMA(0, 1, At, B1); PG8_BAR; PG8_SCHED;
            PG8_LDA(At, 1, 1); PG8_STAGE(PG8_SB(1, 0), b3, voffB); PG8_STAGE(PG8_SB(1, 1), b3 + hstep, voffB); PG8_STAGE(PG8_SA(1, 0), a3, voffA);
            PG8_WAIT_V(8); PG8_WAIT_L(0); PG8_BAR; PG8_MMA(1, 0, At, B0); PG8_MMA(1, 1, At, B1); PG8_BAR; PG8_SCHED;
            } else {
            PG8_LDB(B0, 0, 0); PG8_SCHED; PG8_LDA(At, 0, 0); PG8_STAGE(PG8_SA(1, 1), a1 + hstep, voffA);
            PG8_WAIT_L(8); PG8_BAR; PG8_WAIT_L(0); PG8_MMA(0, 0, At, B0); PG8_BAR; PG8_SCHED;
            PG8_LDB(B1, 0, 1); PG8_STAGE(PG8_SB(0, 0), b2, voffB);
            PG8_BAR; PG8_WAIT_L(0); PG8_MMA(0, 1, At, B1); PG8_BAR;
            PG8_LDA(At, 0, 1); PG8_STAGE(PG8_SA(0, 0), a2, voffA);
            PG8_BAR; PG8_WAIT_L(0); PG8_MMA(1, 0, At, B0); PG8_BAR; PG8_SCHED;
            PG8_STAGE(PG8_SB(0, 1), b2 + hstep, voffB);
            PG8_WAIT_V(6); PG8_BAR; PG8_MMA(1, 1, At, B1); PG8_BAR;
            PG8_LDB(B0, 1, 0); PG8_SCHED; PG8_LDA(At, 1, 0); PG8_STAGE(PG8_SA(0, 1), a2 + hstep, voffA);
            PG8_WAIT_L(8); PG8_BAR; PG8_WAIT_L(0); PG8_MMA(0, 0, At, B0); PG8_BAR; PG8_SCHED;
            PG8_LDB(B1, 1, 1); PG8_STAGE(PG8_SB(1, 0), b3, voffB);
            PG8_BAR; PG8_WAIT_L(0); PG8_MMA(0, 1, At, B1); PG8_BAR;
            PG8_LDA(At, 1, 1); PG8_STAGE(PG8_SA(1, 0), a3, voffA);
            PG8_BAR; PG8_WAIT_L(0); PG8_MMA(1, 0, At, B0); PG8_BAR; PG8_SCHED;
            PG8_STAGE(PG8_SB(1, 1), b3 + hstep, voffB);
            PG8_WAIT_V(6); PG8_BAR; PG8_MMA(1, 1, At, B1); PG8_BAR;
            }
        }
        if constexpr (ALIGN_EPI) { if (wr == 0) PG8_BAR; }
        if constexpr (!Epi::AFTER_DRAIN) { E(acc, cur, wr, wc, fr, fq); S.done(cur); }
        if (!has_next) break;
#pragma unroll
        for (int a = 0; a < 2; ++a)
#pragma unroll
            for (int b = 0; b < 2; ++b)
#pragma unroll
                for (int m = 0; m < 4; ++m)
#pragma unroll
                    for (int n = 0; n < 2; ++n) acc[a][b][m][n] = (f32x4){0.f, 0.f, 0.f, 0.f};
        cur = nxt; cA = nA; cB = nB; ++ui;
        if constexpr (ALIGN_EPI) { if (wr == 1) PG8_BAR; }
    }
    PG8_WAIT_V(0);
    if constexpr (!ALIGN_EPI) { if (wr == 0) PG8_BAR; }
    PG8_BAR;
    if constexpr (Epi::AFTER_DRAIN) { E.fused(acc, cur, wr, wc, fr, fq, lds, wid, lane); S.done(cur); }
#undef PG8_SA
#undef PG8_SB
#undef PG8_STAGE
#undef PG8_LDA
#undef PG8_LDB
#undef PG8_MMA
#undef PG8_WAIT_V
#undef PG8_WAIT_L
#undef PG8_BAR
#undef PG8_SCHED
}
}

#ifndef PG8_SP2
#define PG8_SP2 true
#endif
#ifndef PG8_ALIGN
#define PG8_ALIGN true
#endif

constexpr int NWAVES = 8;
constexpr int BATCH = 4, SEQ = 4096, D = 1024, M = BATCH * SEQ, DEPTH = 4;
constexpr int NQKV = 3 * D, FF = 2816, FF2 = 2 * FF;
constexpr float LN_EPS = 1e-5f, RMS_EPS = 1e-5f;
constexpr float LOG2E = 1.4426950408889634f;
constexpr float QSCALE = 0.125f * LOG2E;
constexpr float ALPHA = 1.6817928305074290861f;
constexpr int PH_PER_LAYER = 9, N_PHASES = DEPTH * PH_PER_LAYER;
#ifndef NAIVE_NA
#define NAIVE_NA 0
#endif
#ifndef NAIVE_DIFF
#define NAIVE_DIFF 0
#endif
#ifndef MK_ONE_LAUNCH
#define MK_ONE_LAUNCH 1
#endif

constexpr size_t MiB = 1u << 20;
constexpr size_t WS_CTL = 0, CTL_ZERO_BYTES = 1 * MiB;
constexpr size_t WS_WQKV = 2 * MiB, WS_WO = 8 * MiB, WS_WIN = 10 * MiB, WS_WOUT = 21 * MiB;
constexpr size_t WS_XB = 28 * MiB;
constexpr size_t WS_ACT = 60 * MiB;
constexpr size_t WS_H = 148 * MiB;
constexpr size_t WS_Q = 148 * MiB, WS_K = 180 * MiB, WS_V = 212 * MiB, WS_O = 244 * MiB;
constexpr size_t WS_Y = 276 * MiB;
constexpr size_t WS_END = 340 * MiB;
constexpr int CW_BAR = 4096;

constexpr int RING_OFF = 0, RING_BYTES = 131072;
constexpr int LDSCTL_OFF = RING_BYTES, MISC_OFF = LDSCTL_OFF + 320;
constexpr int LDS_BYTES = 147456;

#define GAS __attribute__((address_space(1)))
#define LAS __attribute__((address_space(3)))
typedef unsigned short bf16;
typedef unsigned v4u __attribute__((ext_vector_type(4)));
typedef float f32x4 __attribute__((ext_vector_type(4)));
typedef short bf16x8 __attribute__((ext_vector_type(8)));
typedef GAS unsigned gu32;
typedef GAS unsigned long long gu64;
#define RLX_AGENT __ATOMIC_RELAXED, __HIP_MEMORY_SCOPE_AGENT
#define LDS_WAIT() asm volatile("s_waitcnt lgkmcnt(0)" ::: "memory")
#define VM_WAIT() asm volatile("s_waitcnt vmcnt(0)" ::: "memory")
__device__ __forceinline__ unsigned long long rt() { return __builtin_amdgcn_s_memrealtime(); }
__device__ __forceinline__ unsigned f2bf(float f) { unsigned u = __builtin_bit_cast(unsigned, f); return (u + 0x7fffu + ((u >> 16) & 1u)) >> 16; }
__device__ __forceinline__ unsigned pk2(float lo, float hi) { return f2bf(lo) | (f2bf(hi) << 16); }

#define XB_TMO      128
#define XB_XCNT(j)  (256  + 64 * (j))
#define XB_XSUB(j)  (1280 + 64 * (j))
#define XB_XGEN(j)  (2304 + 64 * (j))
#define XB_TOP      3328
#define XB_TOPGEN   3392
#define XCD_BAR_WORDS 3456
#define XB_SPIN_CAP (1u << 18)

__device__ __forceinline__ unsigned xb_ld(unsigned* p)              { return __hip_atomic_load(p, __ATOMIC_RELAXED, __HIP_MEMORY_SCOPE_AGENT); }
__device__ __forceinline__ unsigned xb_add(unsigned* p, unsigned v) { return __hip_atomic_fetch_add(p, v, __ATOMIC_RELAXED, __HIP_MEMORY_SCOPE_AGENT); }
__device__ __forceinline__ unsigned xb_xcc_id() { return (unsigned)__builtin_amdgcn_s_getreg((3 << 11) | 20) & 0xFu; }
#define XB_SPIN(cond, bar) do { unsigned _sp = 0; while (cond) { __builtin_amdgcn_s_sleep(1); \
    if ((++_sp & 255u) == 0u) { if (xb_ld(&(bar)[XB_TMO])) break; if (_sp > XB_SPIN_CAP) { atomicAdd(&(bar)[XB_TMO], 1u); break; } } } } while (0)

struct XcdBarrier {
    unsigned* bar; unsigned x;
    volatile LAS unsigned* st;
};

__device__ __forceinline__ XcdBarrier xcd_barrier_post(unsigned* bar, volatile LAS unsigned* st) {
    XcdBarrier b; b.bar = bar; b.x = xb_xcc_id(); b.st = st;
    if (threadIdx.x == 0) (void)xb_add(&bar[XB_XCNT(b.x)], 1u);
    return b;
}
__device__ __forceinline__ void xcd_barrier_complete(unsigned* bar, unsigned x, unsigned& nloc, unsigned& nx) {
    const unsigned G = gridDim.x * gridDim.y * gridDim.z;
    unsigned sum, cnt, mine, sp = 0u;
    for (;;) {
        sum = 0u; cnt = 0u; mine = 0u;
#pragma unroll
        for (unsigned j = 0; j < 16; ++j) { const unsigned c = xb_ld(&bar[XB_XCNT(j)]); sum += c; cnt += (c > 0u) ? 1u : 0u; mine = (j == x) ? c : mine; }
        if (sum == G) break;
        __builtin_amdgcn_s_sleep(1);
        if ((++sp & 255u) == 0u) { if (xb_ld(&bar[XB_TMO])) break; if (sp > XB_SPIN_CAP) { atomicAdd(&bar[XB_TMO], 1u); break; } }
    }
    nloc = mine > 0u ? mine : 1u; nx = cnt > 0u ? cnt : 1u;
}

__device__ __forceinline__ void xcd_barrier(const XcdBarrier& b) {
    asm volatile("s_waitcnt vmcnt(0)" ::: "memory");
    __syncthreads();
    if (threadIdx.x == 0) {
        unsigned* bar = b.bar;
        __builtin_amdgcn_s_waitcnt(0);
        unsigned nloc = b.st[0], nx = b.st[1];
        if (nloc == 0u) { xcd_barrier_complete(bar, b.x, nloc, nx); b.st[0] = nloc; b.st[1] = nx; }
        const unsigned old = xb_add(&bar[XB_XSUB(b.x)], 1u);
        const unsigned gen = old / nloc;
        if (old + 1u == (gen + 1u) * nloc) {
            __builtin_amdgcn_fence(__ATOMIC_RELEASE, "agent");
            asm volatile("s_waitcnt vmcnt(0)" ::: "memory");
            const unsigned og = xb_add(&bar[XB_TOP], 1u);
            const unsigned tg = og / nx;
            if (og + 1u == (tg + 1u) * nx) xb_add(&bar[XB_TOPGEN], 1u);
            else XB_SPIN(xb_ld(&bar[XB_TOPGEN]) == tg, bar);
            __builtin_amdgcn_fence(__ATOMIC_ACQUIRE, "agent");
            xb_add(&bar[XB_XGEN(b.x)], 1u);
            asm volatile("s_waitcnt vmcnt(0)" ::: "memory");
        } else {
            XB_SPIN(xb_ld(&bar[XB_XGEN(b.x)]) == gen, bar);
            __builtin_amdgcn_fence(__ATOMIC_ACQUIRE, "agent");
            asm volatile("s_waitcnt vmcnt(0)" ::: "memory");
        }
    }
    __syncthreads();
}


struct Args { const float* in[18]; float* out; unsigned char* ws; int ph_lo, ph_hi; };

struct Frame {
    LAS unsigned char* lds;
    volatile LAS unsigned* MISC;
    gu32* ctl;
    int tid, lane, wave, G, vcu;
};

__device__ __forceinline__ float wave_sum(float v) {
#pragma unroll
    for (int o = 1; o < 64; o <<= 1) v += __shfl_xor(v, o);
    return v;
}
__device__ __forceinline__ float wave_max(float v) {
#pragma unroll
    for (int o = 1; o < 64; o <<= 1) v = fmaxf(v, __shfl_xor(v, o));
    return v;
}
__device__ __forceinline__ float bf2f(unsigned short u) { return __builtin_bit_cast(float, (unsigned)u << 16); }

__device__ __forceinline__ void p0_transpose_item(const float* W, int K, int N, bf16* WT, int row_off, LAS float* scr, int item, int lane) {
    const int nblk = N / 32, kb = item / nblk, nb = item % nblk, k0 = 64 * kb, n0 = 32 * nb;
#pragma unroll 8
    for (int i = 0; i < 32; ++i) { const int kk = 2 * i + (lane >> 5); scr[kk * 33 + (lane & 31)] = W[(size_t)(k0 + kk) * N + n0 + (lane & 31)]; }
    LDS_WAIT(); asm volatile("" ::: "memory");
    const int c = lane & 7;
#pragma unroll
    for (int j = 0; j < 4; ++j) { const int n = (lane >> 3) + 8 * j; const LAS float* s = scr + (8 * c) * 33 + n;
        v4u o; o.x = pk2(s[0 * 33], s[1 * 33]); o.y = pk2(s[2 * 33], s[3 * 33]); o.z = pk2(s[4 * 33], s[5 * 33]); o.w = pk2(s[6 * 33], s[7 * 33]);
        *(GAS v4u*)(WT + (size_t)(row_off + n0 + n) * K + k0 + 8 * c) = o; }
    LDS_WAIT(); asm volatile("" ::: "memory");
}

__device__ __forceinline__ void ph_convert(const Args& a, Frame& F, int L) {
    LAS float* scr = (LAS float*)(F.lds + RING_OFF + F.wave * 16384);
    const int gw = F.vcu * NWAVES + F.wave, NGW = F.G * NWAVES;
    const int j = L >> 1;
    const float* wqkv = ((L & 1) ? a.in[5] : a.in[1]) + (size_t)j * D * NQKV;
    const float* wo = ((L & 1) ? a.in[8] : a.in[2]) + (size_t)j * D * D;
    const float* win = a.in[10] + (size_t)L * D * FF2;
    const float* wout = a.in[14] + (size_t)L * FF * D;
    bf16* WQKV = (bf16*)(a.ws + WS_WQKV); bf16* WO = (bf16*)(a.ws + WS_WO); bf16* WIN = (bf16*)(a.ws + WS_WIN); bf16* WOUT = (bf16*)(a.ws + WS_WOUT);
    constexpr int I_QKV = (D / 64) * (NQKV / 32), I_O = (D / 64) * (D / 32), I_IN = (D / 64) * (FF2 / 32), I_OUT = (FF / 64) * (D / 32);
    constexpr int NITEMS = I_QKV + I_O + I_IN + I_OUT;
    for (int it = gw; it < NITEMS; it += NGW) {
        int r = it;
        if (r < I_QKV) { p0_transpose_item(wqkv, D, NQKV, WQKV, 0, scr, r, F.lane); continue; } r -= I_QKV;
        if (r < I_O) { p0_transpose_item(wo, D, D, WO, 0, scr, r, F.lane); continue; } r -= I_O;
        if (r < I_IN) { p0_transpose_item(win, D, FF2, WIN, 0, scr, r, F.lane); continue; } r -= I_IN;
        p0_transpose_item(wout, FF, D, WOUT, 0, scr, r, F.lane);
    }
    if (L == 0) {
        bf16* XB = (bf16*)(a.ws + WS_XB);
        for (int m = gw; m < M; m += NGW) {
            const GAS f32x4* xr = (const GAS f32x4*)(a.in[0] + (size_t)m * D) + F.lane;
            GAS unsigned long long* o8 = (GAS unsigned long long*)(XB + (size_t)m * D) + F.lane;
#pragma unroll
            for (int q = 0; q < 4; ++q) { const f32x4 v = xr[64 * q]; o8[64 * q] = (unsigned long long)pk2(v.x, v.y) | ((unsigned long long)pk2(v.z, v.w) << 32); }
        }
    }
}

__device__ __forceinline__ void ph_ln(const Args& a, Frame& F, int L, int which) {
    const int gw = F.vcu * NWAVES + F.wave, NGW = F.G * NWAVES;
    const float* xin = (L == 0 && which == 0) ? a.in[0] : a.out;
    const float* Y = (const float*)(a.ws + WS_Y);
    const float* g = a.in[16] + (size_t)(L * 2 + which) * D; const float* bb = a.in[17] + (size_t)(L * 2 + which) * D;
    bf16* XB = (bf16*)(a.ws + WS_XB);
    f32x4 gv[4], bv[4];
#pragma unroll
    for (int q = 0; q < 4; ++q) { gv[q] = ((const GAS f32x4*)g)[F.lane + 64 * q]; bv[q] = ((const GAS f32x4*)bb)[F.lane + 64 * q]; }
    for (int m = gw; m < M; m += NGW) {
        const GAS f32x4* xr = (const GAS f32x4*)(xin + (size_t)m * D) + F.lane;
        const GAS f32x4* yr = (const GAS f32x4*)(Y + (size_t)m * D) + F.lane;
        f32x4 v[4]; float s = 0.f;
#pragma unroll
        for (int q = 0; q < 4; ++q) { v[q] = xr[64 * q] * ALPHA + yr[64 * q]; s += (v[q].x + v[q].y) + (v[q].z + v[q].w); }
        const float mean = wave_sum(s) * (1.f / D); float s2 = 0.f;
#pragma unroll
        for (int q = 0; q < 4; ++q) { v[q] = v[q] - mean; s2 += (v[q].x * v[q].x + v[q].y * v[q].y) + (v[q].z * v[q].z + v[q].w * v[q].w); }
        const float rstd = 1.f / sqrtf(wave_sum(s2) * (1.f / D) + LN_EPS);
        GAS f32x4* orow = (GAS f32x4*)(a.out + (size_t)m * D) + F.lane;
        GAS unsigned long long* o8 = (GAS unsigned long long*)(XB + (size_t)m * D) + F.lane;
#pragma unroll
        for (int q = 0; q < 4; ++q) { const f32x4 o = v[q] * rstd * gv[q] + bv[q]; orow[64 * q] = o;
            o8[64 * q] = (unsigned long long)pk2(o.x, o.y) | ((unsigned long long)pk2(o.z, o.w) << 32); }
    }
}

__device__ __forceinline__ void ph_conv(const Args& a, Frame& F, int L) {
    const bf16* H = (const bf16*)(a.ws + WS_H); bf16* ACT = (bf16*)(a.ws + WS_ACT);
    const float* cw = a.in[12] + (size_t)L * 3 * FF2; const float* cb = a.in[13] + (size_t)L * FF2;
    constexpr int CPR = FF / 8;
    const long total = (long)M * CPR, nthr = (long)F.G * NWAVES * 64;
    for (long idx = (long)F.vcu * NWAVES * 64 + F.tid; idx < total; idx += nthr) {
        const int row = (int)(idx / CPR), ch = (int)(idx % CPR), col = ch * 8, t = row % SEQ;
        float uo[8], go[8];
#pragma unroll
        for (int e = 0; e < 8; ++e) { uo[e] = cb[col + e]; go[e] = cb[FF + col + e]; }
#pragma unroll
        for (int k = 0; k < 3; ++k) {
            const int tt = t + k - 1; if (tt < 0 || tt >= SEQ) continue;
            const bf16* hp = H + (size_t)(row + k - 1) * FF2 + col;
            const bf16x8 hu = *(const bf16x8*)hp, hg = *(const bf16x8*)(hp + FF);
#pragma unroll
            for (int e = 0; e < 8; ++e) { uo[e] += cw[(size_t)k * FF2 + col + e] * bf2f((unsigned short)hu[e]); go[e] += cw[(size_t)k * FF2 + FF + col + e] * bf2f((unsigned short)hg[e]); }
        }
        v4u o; float r[8];
#pragma unroll
        for (int e = 0; e < 8; ++e) r[e] = uo[e] * (0.5f * go[e] * (1.0f + erff(go[e] * 0.70710678118654752f)));
        o.x = pk2(r[0], r[1]); o.y = pk2(r[2], r[3]); o.z = pk2(r[4], r[5]); o.w = pk2(r[6], r[7]);
        *(GAS v4u*)(ACT + (size_t)row * FF + col) = o;
    }
}

__device__ __forceinline__ void diff_scores(const bf16* kp, const LAS float* qs, float& s1, float& s2) {
    s1 = 0.f; s2 = 0.f;
    asm volatile("" ::: "memory");
#pragma unroll 4
    for (int c = 0; c < 16; ++c) {
        asm volatile("" ::: "memory");
        const bf16x8 kv = *(const bf16x8*)(kp + c * 8);
        const f32x4 q0 = *(const LAS f32x4*)(qs + c * 8), q1 = *(const LAS f32x4*)(qs + c * 8 + 4);
        float acc = q0.x * bf2f((unsigned short)kv[0]) + q0.y * bf2f((unsigned short)kv[1]) + q0.z * bf2f((unsigned short)kv[2]) + q0.w * bf2f((unsigned short)kv[3])
                  + q1.x * bf2f((unsigned short)kv[4]) + q1.y * bf2f((unsigned short)kv[5]) + q1.z * bf2f((unsigned short)kv[6]) + q1.w * bf2f((unsigned short)kv[7]);
        if (c < 8) s1 += acc; else s2 += acc;
    }
}
__device__ __forceinline__ void naive_diff_attn(const Args& a, Frame& F, int L) {
    const int gw = F.vcu * NWAVES + F.wave, NGW = F.G * NWAVES, lane = F.lane;
    const int j = L >> 1;
    const float lam_init = (L == 0) ? 0.2f : 0.47071301834358416f;
    const float* lf = a.in[3] + (size_t)j * 4 * 64;
    const float lam = expf(wave_sum(lf[lane] * lf[64 + lane])) - expf(wave_sum(lf[128 + lane] * lf[192 + lane])) + lam_init;
    const float* sg = a.in[4] + (size_t)j * 128;
    const float g0 = sg[lane], g1 = sg[64 + lane];
    const bf16* Q = (const bf16*)(a.ws + WS_Q); const bf16* K = (const bf16*)(a.ws + WS_K); const bf16* V = (const bf16*)(a.ws + WS_V); bf16* O = (bf16*)(a.ws + WS_O);
    LAS float* qs = (LAS float*)(F.lds + RING_OFF) + F.wave * 128;
    for (int task = gw; task < M * 8; task += NGW) {
        const int h = task & 7, row = task >> 3, b = row / SEQ, t = row % SEQ;
        const bf16* qp = Q + (size_t)row * D + h * 128;
        qs[lane] = bf2f(qp[lane]); qs[64 + lane] = bf2f(qp[64 + lane]);
        LDS_WAIT(); asm volatile("" ::: "memory");
        const float c2 = exp2f(-(float)(h + 1)) * LOG2E;
        const bf16* Kb = K + (size_t)b * SEQ * D + h * 128; const bf16* Vb = V + (size_t)b * SEQ * D + h * 128;
        float m1 = -1e30f, l1 = 0.f, m2 = -1e30f, l2 = 0.f;
        for (int tile = 0; tile < SEQ / 64; ++tile) {
            const int s = tile * 64 + lane; float s1, s2; diff_scores(Kb + (size_t)s * D, qs, s1, s2);
            const float pen = c2 * fabsf((float)(t - s)); s1 -= pen; s2 -= pen;
            float mn = fmaxf(m1, s1); l1 = l1 * exp2f(m1 - mn) + exp2f(s1 - mn); m1 = mn;
            mn = fmaxf(m2, s2); l2 = l2 * exp2f(m2 - mn) + exp2f(s2 - mn); m2 = mn;
        }
        const float M1 = wave_max(m1), M2 = wave_max(m2);
        const float i1 = 1.f / wave_sum(l1 * exp2f(m1 - M1)), i2 = lam / wave_sum(l2 * exp2f(m2 - M2));
        float o0 = 0.f, o1 = 0.f;
        for (int tile = 0; tile < SEQ / 64; ++tile) {
            const int s = tile * 64 + lane; float s1, s2; diff_scores(Kb + (size_t)s * D, qs, s1, s2);
            const float pen = c2 * fabsf((float)(t - s)); s1 -= pen; s2 -= pen;
            const float av = exp2f(s1 - M1) * i1 - exp2f(s2 - M2) * i2;
            const bf16* vp = Vb + (size_t)(tile * 64) * D + lane;
#pragma unroll 8
            for (int jj = 0; jj < 64; ++jj) { const float aj = __shfl(av, jj); o0 += aj * bf2f(vp[(size_t)jj * D]); o1 += aj * bf2f(vp[(size_t)jj * D + 64]); }
        }
        const float ms = wave_sum(o0 * o0 + o1 * o1) * (1.f / 128.f);
        const float r = (1.f / sqrtf(ms + RMS_EPS)) * (1.f - lam_init);
        bf16* op = O + (size_t)row * D + h * 128;
        op[lane] = (bf16)f2bf(o0 * r * g0); op[64 + lane] = (bf16)f2bf(o1 * r * g1);
        asm volatile("" ::: "memory");
    }
}

namespace da {
typedef short bf16x8 __attribute__((ext_vector_type(8)));
typedef short s16x4 __attribute__((ext_vector_type(4)));
typedef float f32x16 __attribute__((ext_vector_type(16)));
typedef float f32x4v __attribute__((ext_vector_type(4)));
typedef unsigned u32x2v __attribute__((ext_vector_type(2)));
constexpr int SLOT = 32768, EXS = 129;
constexpr float THR = 6.0f;
__device__ __forceinline__ s16x4 vtr(const LAS unsigned char* p) { return __builtin_bit_cast(s16x4, __builtin_amdgcn_ds_read_tr16_b64_v4i16((LAS s16x4*)p)); }
__device__ __forceinline__ unsigned cvtpk(float lo, float hi) { typedef float f2 __attribute__((ext_vector_type(2))); typedef __bf16 b2 __attribute__((ext_vector_type(2))); f2 v = {lo, hi}; b2 b = __builtin_convertvector(v, b2); return __builtin_bit_cast(unsigned, b); }
__device__ __forceinline__ bf16x8 pack8(const f32x16& p, int base) {
    typedef unsigned u4 __attribute__((ext_vector_type(4)));
    u4 w; w.x = cvtpk(p[base], p[base + 1]); w.y = cvtpk(p[base + 2], p[base + 3]); w.z = cvtpk(p[base + 4], p[base + 5]); w.w = cvtpk(p[base + 6], p[base + 7]);
    return __builtin_bit_cast(bf16x8, w);
}
__device__ __forceinline__ void issue_tile(const bf16* Kh, const bf16* Vh, int tile, LAS unsigned char* slot, int wave, int lane) {
#pragma unroll
    for (int i = 0; i < 4; ++i) {
        const int p = wave + 8 * i; const bf16* src;
        if (i < 2) src = Kh + (size_t)(tile * 64 + lane) * D + i * 64 + wave * 8;
        else { const int pv = p - 16, db = pv >> 2, kg = pv & 3; src = Vh + (size_t)(tile * 64 + 16 * kg + (lane >> 2)) * D + 32 * db + (lane & 3) * 8; }
        __builtin_amdgcn_global_load_lds((const unsigned*)src, (LAS unsigned*)(slot + p * 1024), 16, 0, 0);
    }
}
__device__ __forceinline__ void unit(int b, int h, int qblk, const bf16* Q, const bf16* K, const bf16* V, bf16* O, LAS unsigned char* ring, float lam, float one_m_li, const float* sg, int wave, int lane) {
    const int r32 = lane & 31, hi = lane >> 5, c = wave >> 2, qs = wave & 3;
    const size_t rowbase = (size_t)b * SEQ; const int q0 = qblk * 128 + 32 * qs;
    const bf16* Kh = K + rowbase * D + h * 128; const bf16* Vh = V + rowbase * D + h * 128;
    issue_tile(Kh, Vh, 0, ring, wave, lane);
    const bf16* Qw = Q + (rowbase + q0 + r32) * D + h * 128 + c * 64 + hi * 8;
    bf16x8 qr[4];
#pragma unroll
    for (int d0 = 0; d0 < 4; ++d0) qr[d0] = *(const bf16x8*)(Qw + d0 * 16);
    f32x16 o[4];
#pragma unroll
    for (int db = 0; db < 4; ++db)
#pragma unroll
        for (int r = 0; r < 16; ++r) o[db][r] = 0.f;
    float m = -1e30f, l = 0.f;
    const float c2 = exp2f(-(float)(h + 1)) * LOG2E;
    const float qpos = (float)(q0 + r32 - 4 * hi);
    for (int i = 0; i < SEQ / 64; ++i) {
        asm volatile("s_waitcnt vmcnt(0)" ::: "memory"); __syncthreads();
        if (i + 1 < SEQ / 64) issue_tile(Kh, Vh, i + 1, ring + ((i + 1) & 1) * SLOT, wave, lane);
        const LAS unsigned char* slot = ring + (i & 1) * SLOT;
        const LAS unsigned char* kb = slot + c * 8192 + hi * 1024 + r32 * 16;
        f32x16 p0, p1;
#pragma unroll
        for (int r = 0; r < 16; ++r) { p0[r] = 0.f; p1[r] = 0.f; }
#pragma unroll
        for (int d0 = 0; d0 < 4; ++d0) {
            const bf16x8 b0 = *(const LAS bf16x8*)(kb + d0 * 2048), b1 = *(const LAS bf16x8*)(kb + d0 * 2048 + 512);
            p0 = __builtin_amdgcn_mfma_f32_32x32x16_bf16(b0, qr[d0], p0, 0, 0, 0);
            p1 = __builtin_amdgcn_mfma_f32_32x32x16_bf16(b1, qr[d0], p1, 0, 0, 0);
        }
        const float dq = qpos - (float)(64 * i);
        float rm = -1e30f;
#pragma unroll
        for (int r = 0; r < 16; ++r) { const float kc = (float)((r & 3) + 8 * (r >> 2));
            p0[r] = __builtin_fmaf(-c2, __builtin_fabsf(dq - kc), p0[r]); p1[r] = __builtin_fmaf(-c2, __builtin_fabsf(dq - kc - 32.f), p1[r]);
            rm = __builtin_fmaxf(rm, __builtin_fmaxf(p0[r], p1[r])); }
        rm = __builtin_fmaxf(rm, __shfl_xor(rm, 32));
        const bool grow = rm > m + THR;
        if (__any(grow)) {
            const float mn = grow ? rm : m; const float al = __builtin_amdgcn_exp2f(m - mn); l *= al; m = mn;
#pragma unroll
            for (int db = 0; db < 4; ++db)
#pragma unroll
                for (int r = 0; r < 16; ++r) o[db][r] *= al;
        }
        float ps = 0.f;
#pragma unroll
        for (int r = 0; r < 16; ++r) { p0[r] = __builtin_amdgcn_exp2f(p0[r] - m); p1[r] = __builtin_amdgcn_exp2f(p1[r] - m); ps += p0[r] + p1[r]; }
        l += ps;
        bf16x8 pb[4]; pb[0] = pack8(p0, 0); pb[1] = pack8(p0, 8); pb[2] = pack8(p1, 0); pb[3] = pack8(p1, 8);
        const LAS unsigned char* vb = slot + 16384 + (4 * hi + ((lane & 15) >> 2)) * 64 + ((lane >> 4) & 1) * 32 + (lane & 3) * 8;
#pragma unroll
        for (int db = 0; db < 4; ++db)
#pragma unroll
            for (int ks = 0; ks < 4; ++ks) {
                const s16x4 lo = vtr(vb + db * 4096 + ks * 1024), hh = vtr(vb + db * 4096 + ks * 1024 + 512);
                const bf16x8 vf = (bf16x8){lo[0], lo[1], lo[2], lo[3], hh[0], hh[1], hh[2], hh[3]};
                o[db] = __builtin_amdgcn_mfma_f32_32x32x16_bf16(vf, pb[ks], o[db], 0, 0, 0);
            }
    }
    l += __shfl_xor(l, 32); const float inv = 1.f / l;
    __syncthreads();
    LAS float* ex = (LAS float*)ring + (qs * 32 + r32) * EXS;
    if (c == 1) { const float f = inv * lam;
#pragma unroll
        for (int db = 0; db < 4; ++db)
#pragma unroll
            for (int r = 0; r < 16; ++r) ex[32 * db + (r & 3) + 8 * (r >> 2) + 4 * hi] = o[db][r] * f; }
    __syncthreads();
    if (c == 0) {
        float ss = 0.f;
#pragma unroll
        for (int db = 0; db < 4; ++db)
#pragma unroll
            for (int r = 0; r < 16; ++r) { const float v = o[db][r] * inv - ex[32 * db + (r & 3) + 8 * (r >> 2) + 4 * hi]; o[db][r] = v; ss += v * v; }
        ss += __shfl_xor(ss, 32);
        const float rn = (1.f / sqrtf(ss * (1.f / 128.f) + RMS_EPS)) * one_m_li;
        bf16* orow = O + (rowbase + q0 + r32) * D + h * 128;
#pragma unroll
        for (int db = 0; db < 4; ++db)
#pragma unroll
            for (int g4 = 0; g4 < 4; ++g4) { const int d = 32 * db + 8 * g4 + 4 * hi; const f32x4v gg = *(const f32x4v*)(sg + d);
                u32x2v w; w.x = cvtpk(o[db][4 * g4] * rn * gg.x, o[db][4 * g4 + 1] * rn * gg.y); w.y = cvtpk(o[db][4 * g4 + 2] * rn * gg.z, o[db][4 * g4 + 3] * rn * gg.w);
                *(u32x2v*)(orow + d) = w; }
    }
    __syncthreads();
}
}
__device__ __forceinline__ void ph_diff_attn(const Args& a, Frame& F, int L) {
    const int j = L >> 1, lane = F.lane;
    const float lam_init = (L == 0) ? 0.2f : 0.47071301834358416f;
    const float* lf = a.in[3] + (size_t)j * 4 * 64;
    const float lam = expf(wave_sum(lf[lane] * lf[64 + lane])) - expf(wave_sum(lf[128 + lane] * lf[192 + lane])) + lam_init;
    const float* sg = a.in[4] + (size_t)j * 128;
    const bf16* Q = (const bf16*)(a.ws + WS_Q); const bf16* K = (const bf16*)(a.ws + WS_K); const bf16* V = (const bf16*)(a.ws + WS_V); bf16* O = (bf16*)(a.ws + WS_O);
    for (int u = F.vcu; u < BATCH * 8 * (SEQ / 128); u += F.G) {
        const int bh = u >> 5, qblk = u & 31;
        da::unit(bh >> 3, bh & 7, qblk, Q, K, V, O, F.lds + RING_OFF, lam, 1.f - lam_init, sg, F.wave, lane);
    }
}

namespace na {
using da::bf16x8; using da::s16x4; using da::f32x16; using da::f32x4v; using da::u32x2v;
constexpr int TAB_OFF = MISC_OFF + 512, TAB_PAD = 64, NTAB = 15 * 31;
__device__ __forceinline__ void issue_v(const bf16* Vh, int kr, LAS unsigned char* slot, int lane) {
#pragma unroll
    for (int p = 0; p < 8; ++p) { const int db = p >> 2, kg = p & 3;
        const bf16* src = Vh + (size_t)(kr * 64 + 16 * kg + (lane >> 2)) * D + 32 * db + (lane & 3) * 8;
        __builtin_amdgcn_global_load_lds((const unsigned*)src, (LAS unsigned*)(slot + p * 1024), 16, 0, 0); }
}
__device__ __forceinline__ void load_k(bf16x8 (&kf)[8], const bf16* Kh, int kr, int r32, int hi) {
#pragma unroll
    for (int d0 = 0; d0 < 4; ++d0)
#pragma unroll
        for (int hf = 0; hf < 2; ++hf) kf[2 * d0 + hf] = *(const bf16x8*)(Kh + (size_t)(kr * 64 + 32 * hf + r32) * D + 16 * d0 + 8 * hi);
}
__device__ __forceinline__ void wg_task(int b, int h, int r4, const bf16* Q, const bf16* K, const bf16* V, bf16* O, const float* rpb_h, LAS unsigned char* lds, int wave, int lane, int tid) {
    LAS float* tabr = (LAS float*)(lds + TAB_OFF);
    __syncthreads();
    if (tid < NTAB) tabr[TAB_PAD + tid] = rpb_h[tid] * LOG2E;
    __syncthreads();
    const int r32 = lane & 31, hi = lane >> 5, qb = wave & 1;
    const int r = r4 * 4 + (wave >> 1), rs = min(max(r - 4, 0), 56);
    const size_t rowbase = (size_t)b * SEQ;
    const bf16* Kh = K + rowbase * D + h * 64; const bf16* Vh = V + rowbase * D + h * 64;
    LAS unsigned char* vbuf = lds + RING_OFF + wave * 16384;
    issue_v(Vh, rs, vbuf, lane);
    bf16x8 kf[8]; load_k(kf, Kh, rs, r32, hi);
    const int cq = 32 * qb + r32, cs = min(max(cq - 8, 0), 48), lo = cs - 4 * hi, lp = 4 * hi - cq + 15;
    bf16x8 qr[4];
#pragma unroll
    for (int d0 = 0; d0 < 4; ++d0) qr[d0] = *(const bf16x8*)(Q + (rowbase + r * 64 + cq) * D + h * 64 + 16 * d0 + 8 * hi);
    f32x16 o[2];
#pragma unroll
    for (int db = 0; db < 2; ++db)
#pragma unroll
        for (int e = 0; e < 16; ++e) o[db][e] = 0.f;
    float m = -1e30f, l = 0.f;
    for (int i = 0; i < 8; ++i) {
        const int kr = rs + i;
        asm volatile("s_waitcnt vmcnt(0)" ::: "memory");
        if (i + 1 < 8) issue_v(Vh, kr + 1, vbuf + ((i + 1) & 1) * 8192, lane);
        const LAS float* tp = tabr + TAB_PAD + (kr - r + 7) * 31 + lp;
        f32x16 p0, p1;
#pragma unroll
        for (int e = 0; e < 16; ++e) { p0[e] = 0.f; p1[e] = 0.f; }
#pragma unroll
        for (int d0 = 0; d0 < 4; ++d0) {
            p0 = __builtin_amdgcn_mfma_f32_32x32x16_bf16(kf[2 * d0], qr[d0], p0, 0, 0, 0);
            p1 = __builtin_amdgcn_mfma_f32_32x32x16_bf16(kf[2 * d0 + 1], qr[d0], p1, 0, 0, 0);
        }
        if (i + 1 < 8) load_k(kf, Kh, kr + 1, r32, hi);
        float rm = -1e30f;
#pragma unroll
        for (int e = 0; e < 16; ++e) { const int cst = (e & 3) + 8 * (e >> 2);
            const bool v0 = (unsigned)(cst - lo) <= 15u, v1 = (unsigned)(cst + 32 - lo) <= 15u;
            const float s0 = p0[e] + tp[cst], s1 = p1[e] + tp[cst + 32];
            p0[e] = v0 ? s0 : -1e30f; p1[e] = v1 ? s1 : -1e30f;
            rm = __builtin_fmaxf(rm, __builtin_fmaxf(p0[e], p1[e])); }
        rm = __builtin_fmaxf(rm, __shfl_xor(rm, 32));
        const bool grow = rm > m + da::THR;
        if (__any(grow)) {
            const float mn = grow ? rm : m; const float al = __builtin_amdgcn_exp2f(m - mn); l *= al; m = mn;
#pragma unroll
            for (int db = 0; db < 2; ++db)
#pragma unroll
                for (int e = 0; e < 16; ++e) o[db][e] *= al;
        }
        float ps = 0.f;
#pragma unroll
        for (int e = 0; e < 16; ++e) { p0[e] = __builtin_amdgcn_exp2f(p0[e] - m); p1[e] = __builtin_amdgcn_exp2f(p1[e] - m); ps += p0[e] + p1[e]; }
        l += ps;
        bf16x8 pb[4]; pb[0] = da::pack8(p0, 0); pb[1] = da::pack8(p0, 8); pb[2] = da::pack8(p1, 0); pb[3] = da::pack8(p1, 8);
        const LAS unsigned char* vb = vbuf + (i & 1) * 8192 + (4 * hi + ((lane & 15) >> 2)) * 64 + ((lane >> 4) & 1) * 32 + (lane & 3) * 8;
#pragma unroll
        for (int db = 0; db < 2; ++db)
#pragma unroll
            for (int ks = 0; ks < 4; ++ks) {
                const s16x4 lw = da::vtr(vb + db * 4096 + ks * 1024), hh = da::vtr(vb + db * 4096 + ks * 1024 + 512);
                const bf16x8 vf = (bf16x8){lw[0], lw[1], lw[2], lw[3], hh[0], hh[1], hh[2], hh[3]};
                o[db] = __builtin_amdgcn_mfma_f32_32x32x16_bf16(vf, pb[ks], o[db], 0, 0, 0);
            }
    }
    l += __shfl_xor(l, 32); const float inv = 1.f / l;
    bf16* orow = O + (rowbase + r * 64 + cq) * D + h * 64;
#pragma unroll
    for (int db = 0; db < 2; ++db)
#pragma unroll
        for (int g4 = 0; g4 < 4; ++g4) { const int d = 32 * db + 8 * g4 + 4 * hi;
            u32x2v w; w.x = da::cvtpk(o[db][4 * g4] * inv, o[db][4 * g4 + 1] * inv); w.y = da::cvtpk(o[db][4 * g4 + 2] * inv, o[db][4 * g4 + 3] * inv);
            *(u32x2v*)(orow + d) = w; }
}
}
__device__ __forceinline__ void ph_na_attn(const Args& a, Frame& F, int L) {
    const int j = L >> 1;
    const float* rpb = a.in[7] + (size_t)j * 16 * na::NTAB;
    const bf16* Q = (const bf16*)(a.ws + WS_Q); const bf16* K = (const bf16*)(a.ws + WS_K); const bf16* V = (const bf16*)(a.ws + WS_V); bf16* O = (bf16*)(a.ws + WS_O);
    for (int wt = F.vcu; wt < BATCH * 16 * 16; wt += F.G) {
        const int r4 = wt & 15, h = (wt >> 4) & 15, b = wt >> 8;
        na::wg_task(b, h, r4, Q, K, V, O, rpb + (size_t)h * na::NTAB, F.lds, F.wave, F.lane, F.tid);
    }
}

__device__ __forceinline__ void naive_na_attn(const Args& a, Frame& F, int L) {
    const int gw = F.vcu * NWAVES + F.wave, NGW = F.G * NWAVES, lane = F.lane;
    const int j = L >> 1;
    const float* rpb = a.in[7] + (size_t)j * 16 * 15 * 31;
    const bf16* Q = (const bf16*)(a.ws + WS_Q); const bf16* K = (const bf16*)(a.ws + WS_K); const bf16* V = (const bf16*)(a.ws + WS_V); bf16* O = (bf16*)(a.ws + WS_O);
    LAS float* qs = (LAS float*)(F.lds + RING_OFF) + F.wave * 128;
    for (int task = gw; task < M * 16; task += NGW) {
        const int h = task & 15, row = task >> 4, b = row / SEQ, t = row % SEQ, r = t >> 6, c = t & 63;
        const int rs = min(max(r - 4, 0), 56), cs = min(max(c - 8, 0), 48);
        qs[lane] = bf2f(Q[(size_t)row * D + h * 64 + lane]);
        LDS_WAIT(); asm volatile("" ::: "memory");
        const bf16* Kb = K + (size_t)b * SEQ * D + h * 64; const bf16* Vb = V + (size_t)b * SEQ * D + h * 64;
        float sc[2];
#pragma unroll
        for (int hf = 0; hf < 2; ++hf) {
            const int kk = lane + 64 * hf, i = kk >> 4, jj = kk & 15, kt = (rs + i) * 64 + cs + jj;
            const bf16* kp = Kb + (size_t)kt * D; float acc = 0.f;
#pragma unroll
            for (int cc = 0; cc < 8; ++cc) { const bf16x8 kv = *(const bf16x8*)(kp + cc * 8);
#pragma unroll
                for (int e = 0; e < 8; ++e) acc += qs[cc * 8 + e] * bf2f((unsigned short)kv[e]); }
            sc[hf] = acc + rpb[((size_t)h * 15 + (rs + i - r + 7)) * 31 + (cs + jj - c + 15)] * LOG2E;
        }
        const float mx = wave_max(fmaxf(sc[0], sc[1]));
        const float p0 = exp2f(sc[0] - mx), p1 = exp2f(sc[1] - mx);
        const float inv = 1.f / wave_sum(p0 + p1);
        float o = 0.f;
#pragma unroll 8
        for (int kk = 0; kk < 128; ++kk) { const int i = kk >> 4, jj = kk & 15, kt = (rs + i) * 64 + cs + jj;
            const float pk = __shfl(kk < 64 ? p0 : p1, kk & 63); o += pk * bf2f(Vb[(size_t)kt * D + lane]); }
        O[(size_t)row * D + h * 64 + lane] = (bf16)f2bf(o * inv);
        asm volatile("" ::: "memory");
    }
}

template <int S> __device__ __forceinline__ void run_phase(const Args& args, Frame& F0, int L) {
    Frame F = F0; { int t_ = threadIdx.x; asm volatile("" : "+v"(t_)); F.tid = t_; F.lane = t_ & 63; F.wave = __builtin_amdgcn_readfirstlane(t_ >> 6); }
    const int j = L >> 1; const bool na = (L & 1) != 0;
    bf16* WQKV = (bf16*)(args.ws + WS_WQKV); bf16* WO = (bf16*)(args.ws + WS_WO); bf16* WIN = (bf16*)(args.ws + WS_WIN); bf16* WOUT = (bf16*)(args.ws + WS_WOUT);
    bf16* XB = (bf16*)(args.ws + WS_XB); bf16* ACT = (bf16*)(args.ws + WS_ACT); bf16* HB = (bf16*)(args.ws + WS_H);
    bf16* QB = (bf16*)(args.ws + WS_Q); bf16* OB = (bf16*)(args.ws + WS_O); float* Y = (float*)(args.ws + WS_Y);
    if constexpr (S == 0) ph_convert(args, F, L);
    else if constexpr (S == 1) {
        pg8::Gemm g{XB, WQKV, M, NQKV, D}; pg8::StaticOrder So; So.init(M, NQKV, F.G, (int)blockIdx.x);
        pg8::EpiBf16<0> E{QB, D, na ? args.in[6] + (size_t)j * NQKV : nullptr, D, (size_t)(WS_K - WS_Q) / 2, QSCALE};
        pg8::gemm_phase<pg8::EpiBf16<0>, pg8::StaticOrder, PG8_ALIGN, PG8_SP2>(F.lds + RING_OFF, g, So, E);
    }
    else if constexpr (S == 2) { if (na) {
#if NAIVE_NA
        naive_na_attn(args, F, L);
#else
        ph_na_attn(args, F, L);
#endif
    } else {
#if NAIVE_DIFF
        naive_diff_attn(args, F, L);
#else
        ph_diff_attn(args, F, L);
#endif
    } }
    else if constexpr (S == 3) {
        pg8::Gemm g{OB, WO, M, D, D}; pg8::StaticOrder So; So.init(M, D, F.G, (int)blockIdx.x);
        pg8::EpiF32 E{Y, D, na ? args.in[9] + (size_t)j * D : nullptr};
        pg8::gemm_phase<pg8::EpiF32, pg8::StaticOrder, PG8_ALIGN, PG8_SP2>(F.lds + RING_OFF, g, So, E);
    }
    else if constexpr (S == 4) ph_ln(args, F, L, 0);
    else if constexpr (S == 5) {
        pg8::Gemm g{XB, WIN, M, FF2, D}; pg8::StaticOrder So; So.init(M, FF2, F.G, (int)blockIdx.x);
        pg8::EpiBf16<0> E{HB, FF2, args.in[11] + (size_t)L * FF2, 0, 0, 1.f};
        pg8::gemm_phase<pg8::EpiBf16<0>, pg8::StaticOrder, PG8_ALIGN, PG8_SP2>(F.lds + RING_OFF, g, So, E);
    }
    else if constexpr (S == 6) ph_conv(args, F, L);
    else if constexpr (S == 7) {
        pg8::Gemm g{ACT, WOUT, M, D, FF}; pg8::StaticOrder So; So.init(M, D, F.G, (int)blockIdx.x);
        pg8::EpiF32 E{Y, D, args.in[15] + (size_t)L * D};
        pg8::gemm_phase<pg8::EpiF32, pg8::StaticOrder, PG8_ALIGN, PG8_SP2>(F.lds + RING_OFF, g, So, E);
    }
    else ph_ln(args, F, L, 1);
}
__device__ __forceinline__ void frame_init(Frame& F, const Args& args, unsigned char* lds) {
    F.lds = (LAS unsigned char*)lds;
    F.MISC = (volatile LAS unsigned*)(F.lds + MISC_OFF);
    F.tid = threadIdx.x; F.lane = F.tid & 63; F.wave = __builtin_amdgcn_readfirstlane(F.tid >> 6);
    F.G = gridDim.x; { const int bx = blockIdx.x; F.vcu = (F.G % 8 == 0) ? (bx % 8) * (F.G / 8) + bx / 8 : bx; }
    F.ctl = (gu32*)(args.ws + WS_CTL);
}
template <int S> __global__ void __launch_bounds__(NWAVES * 64, 2) phase_kernel(Args args) {
    extern __shared__ __attribute__((aligned(16))) unsigned char lds[];
    Frame F; frame_init(F, args, lds);
    run_phase<S>(args, F, args.ph_lo);
}

__global__ void __launch_bounds__(NWAVES * 64, 2) fwd_kernel(Args args) {
    extern __shared__ __attribute__((aligned(16))) unsigned char lds[];
    Frame F; frame_init(F, args, lds);
    for (int u = F.tid; u < (LDS_BYTES - LDSCTL_OFF) / 4; u += NWAVES * 64) ((LAS unsigned*)(F.lds + LDSCTL_OFF))[u] = 0u;
    __syncthreads();
    XcdBarrier bar = xcd_barrier_post((unsigned*)(F.ctl + CW_BAR), F.MISC + 8);
    const int lo = args.ph_lo, hi = args.ph_hi;
    for (int p = lo; p < hi; ++p) {
        const int L = p / PH_PER_LAYER, s = p % PH_PER_LAYER;
        switch (s) {
            case 0: run_phase<0>(args, F, L); break;
            case 1: run_phase<1>(args, F, L); break;
            case 2: run_phase<2>(args, F, L); break;
            case 3: run_phase<3>(args, F, L); break;
            case 4: run_phase<4>(args, F, L); break;
            case 5: run_phase<5>(args, F, L); break;
            case 6: run_phase<6>(args, F, L); break;
            case 7: run_phase<7>(args, F, L); break;
            default: run_phase<8>(args, F, L); break;
        }
        if (p + 1 < hi) xcd_barrier(bar);
    }
}

template <int S> static void launch_phase(int grid, Args a, int L, hipStream_t stream) {
    static bool attr = false;
    if (!attr) { (void)hipFuncSetAttribute((const void*)phase_kernel<S>, hipFuncAttributeMaxDynamicSharedMemorySize, LDS_BYTES); attr = true; }
    a.ph_lo = L; a.ph_hi = S;
    hipLaunchKernelGGL(phase_kernel<S>, dim3(grid), dim3(NWAVES * 64), LDS_BYTES, stream, a);
}
extern "C" void kernel_launch(void* const* d_in, const int* in_sizes, int n_in, void* d_out, int out_size, void* d_ws, size_t ws_size, hipStream_t stream) {
    static int grid = 0;
    if (grid == 0) {
        if (n_in != 18 || in_sizes[0] != M * D || out_size != M * D || ws_size < WS_END) { fprintf(stderr, "kernel_launch: unexpected shapes (n_in %d, in0 %d, out %d, ws %zu)\n", n_in, n_in > 0 ? in_sizes[0] : -1, out_size, ws_size); grid = -1; return; }
        int dev = 0, cus = 0;
        if (hipGetDevice(&dev) != hipSuccess || hipDeviceGetAttribute(&cus, hipDeviceAttributeMultiprocessorCount, dev) != hipSuccess) { grid = -1; return; }
        grid = cus;
    }
    if (grid < 0) return;
    (void)hipMemsetAsync((char*)d_ws + WS_CTL, 0, CTL_ZERO_BYTES, stream);
    Args a{};
    for (int i = 0; i < 18; ++i) a.in[i] = (const float*)d_in[i];
    a.out = (float*)d_out; a.ws = (unsigned char*)d_ws;
#if MK_ONE_LAUNCH
    static bool attr1 = false;
    if (!attr1) { (void)hipFuncSetAttribute((const void*)fwd_kernel, hipFuncAttributeMaxDynamicSharedMemorySize, LDS_BYTES); attr1 = true; }
    a.ph_lo = 0; a.ph_hi = N_PHASES;
    hipLaunchKernelGGL(fwd_kernel, dim3(grid), dim3(NWAVES * 64), LDS_BYTES, stream, a);
#else
    for (int L = 0; L < DEPTH; ++L) {
        launch_phase<0>(grid, a, L, stream); launch_phase<1>(grid, a, L, stream); launch_phase<2>(grid, a, L, stream);
        launch_phase<3>(grid, a, L, stream); launch_phase<4>(grid, a, L, stream); launch_phase<5>(grid, a, L, stream);
        launch_phase<6>(grid, a, L, stream); launch_phase<7>(grid, a, L, stream); launch_phase<8>(grid, a, L, stream);
    }
#endif
}
```

```cpp
#include <hip/hip_runtime.h>
#include <cstdio>
#include <cstdint>
namespace pg8 {
#define PG8_LAS __attribute__((address_space(3)))
typedef unsigned short bf16_t;
typedef short bf16x8 __attribute__((ext_vector_type(8)));
typedef float f32x4 __attribute__((ext_vector_type(4)));
typedef unsigned u32x4 __attribute__((ext_vector_type(4)));
constexpr int BM = 256, BK = 64, HALF = 128, HTB = HALF * BK * 2  , STAGE_BYTES = 8 * HTB, NXCD = 8, WGM = 8;

__host__ __device__ __forceinline__ int lds_byte(int r, int c) { const int st = (r >> 4) * 2 + (c >> 5), rr = r & 15, cc = c & 31, ob = rr * 64 + cc * 2; return st * 1024 + (ob ^ (((ob >> 9) & 1) << 5)); }
__host__ __device__ __forceinline__ void stage_rc(int b, int& R, int& C) { const int st = b / 1024, sb = b % 1024, swz = sb ^ (((sb >> 9) & 1) << 5); R = (st >> 1) * 16 + swz / 64; C = (st & 1) * 32 + (swz % 64) / 2; }
__host__ __device__ __forceinline__ int perm32(int rho) { const int n = rho >> 4, i = rho & 15; return 8 * (i >> 2) + 4 * n + (i & 3); }

struct Unit { int pm, pn; };
struct Gemm { const bf16_t* A; const bf16_t* Bt; int M, N, K; };

struct StaticOrder {
    int nM, nN, nwg, G, c;
    __host__ __device__ void init(int M, int N, int G_, int c_) { nM = M / BM; nN = N / BM; nwg = nM * nN; G = G_; c = c_; }
    __host__ __device__ bool next(int i, Unit& u) const {
        const long L = (long)i * G + c; if (L >= nwg) return false;
        int wgid = (int)L; { const int q = nwg / NXCD, r = nwg % NXCD, xcd = wgid % NXCD, off = wgid / NXCD; wgid = (xcd < r ? xcd * (q + 1) : r * (q + 1) + (xcd - r) * q) + off; }
        const int nig = WGM * nN, gid = wgid / nig, fm = gid * WGM, gsz = (nM - fm) < WGM ? (nM - fm) : WGM;
        u.pm = fm + ((wgid % nig) % gsz); u.pn = (wgid % nig) / gsz; return true;
    }
    __device__ __forceinline__ void a_ready(const Unit&) const {}
    __device__ __forceinline__ void done(const Unit&) const {}
};

__device__ __forceinline__ unsigned cvt_pk_bf16(float lo, float hi) { unsigned r; asm volatile("v_cvt_pk_bf16_f32 %0, %1, %2" : "=v"(r) : "v"(lo), "v"(hi)); return r; }
typedef float f32x2 __attribute__((ext_vector_type(2)));
__device__ __forceinline__ f32x2 gelu_pk(f32x2 v) {
    const f32x2 av = __builtin_elementwise_abs(v), d = av * 0.2316418882f + 1.0f;
    f32x2 t; t.x = __builtin_amdgcn_rcpf(d.x); t.y = __builtin_amdgcn_rcpf(d.y);
    f32x2 q = t * 0.5307027145f + (-0.7265760135f); q = q * t + 0.7107068705f; q = q * t + (-0.142248368f); q = q * t + 0.127414796f; q = q * t;
    const f32x2 s = (v * v) * (-0.72134752044f);
    f32x2 e; e.x = __builtin_amdgcn_exp2f(s.x); e.y = __builtin_amdgcn_exp2f(s.y);
    const f32x2 m = v * (q * e), r = v - m;
    f32x2 o; o.x = v.x < 0.f ? m.x : r.x; o.y = v.y < 0.f ? m.y : r.y; return o;
}

template <int ACT  > struct EpiBf16 {
    static constexpr bool PERM = true, AFTER_DRAIN = false; static_assert(ACT == 0 || ACT == 1, "EpiBf16: ACT is 0 (none) or 1 (gelu_pk)");
    bf16_t* O; int ldc; const float* bias; int split_cols; size_t split_stride; float scale0;
    unsigned* nrm; int rows_per_batch;
    __device__ __forceinline__ void operator()(const f32x4 (&acc)[2][2][4][2], const Unit& u, int wr, int wc, int fr, int fq) const {
        const int row0 = u.pm * BM + wr * 64 + fr; int colt = u.pn * BM; bf16_t* base = O;
        float sc = 1.f; int tsel = 0; if (split_cols) { const int t = colt / split_cols; base += (size_t)t * split_stride; colt -= t * split_cols; if (t == 0) sc = scale0; tsel = t; }
        float mx[2] = {0.f, 0.f};
        const int col0 = colt + wc * 32 + 8 * fq, bcol0 = u.pn * BM + wc * 32 + 8 * fq;
        f32x4 bv[2][2];
#pragma unroll
        for (int bj = 0; bj < 2; ++bj)
#pragma unroll
            for (int n = 0; n < 2; ++n) bv[bj][n] = bias ? *(const f32x4*)(bias + bcol0 + bj * HALF + 4 * n) : (f32x4){0.f, 0.f, 0.f, 0.f};
#pragma unroll
        for (int ai = 0; ai < 2; ++ai)
#pragma unroll
            for (int m = 0; m < 4; ++m) { bf16_t* rowp = base + (size_t)(row0 + ai * HALF + m * 16) * ldc + col0;
#pragma unroll
                for (int bj = 0; bj < 2; ++bj) { f32x4 v0 = acc[ai][bj][m][0] + bv[bj][0], v1 = acc[ai][bj][m][1] + bv[bj][1];
                    if (ACT == 1) { f32x2 a = gelu_pk((f32x2){v0[0], v0[1]}), b = gelu_pk((f32x2){v0[2], v0[3]}), c = gelu_pk((f32x2){v1[0], v1[1]}), d = gelu_pk((f32x2){v1[2], v1[3]});
                        v0 = (f32x4){a.x, a.y, b.x, b.y}; v1 = (f32x4){c.x, c.y, d.x, d.y}; }
                    v0 = v0 * sc; v1 = v1 * sc; u32x4 w; w.x = cvt_pk_bf16(v0[0], v0[1]); w.y = cvt_pk_bf16(v0[2], v0[3]); w.z = cvt_pk_bf16(v1[0], v1[1]); w.w = cvt_pk_bf16(v1[2], v1[3]);
                    *(u32x4*)(rowp + bj * HALF) = w;
                    if (nrm) { float ss = (v0[0] * v0[0] + v0[1] * v0[1]) + (v0[2] * v0[2] + v0[3] * v0[3]) + (v1[0] * v1[0] + v1[1] * v1[1]) + (v1[2] * v1[2] + v1[3] * v1[3]);
                        ss += __shfl_xor(ss, 16); ss += __shfl_xor(ss, 32); mx[bj] = __builtin_fmaxf(mx[bj], ss); } } }
        if (nrm && tsel < 2) {
#pragma unroll
            for (int bj = 0; bj < 2; ++bj) { float v = mx[bj];
                v = __builtin_fmaxf(v, __shfl_xor(v, 1)); v = __builtin_fmaxf(v, __shfl_xor(v, 2)); v = __builtin_fmaxf(v, __shfl_xor(v, 4)); v = __builtin_fmaxf(v, __shfl_xor(v, 8));
                if (fr == 0 && fq == 0) atomicMax(nrm + (((u.pm * BM) / rows_per_batch) * 2 + tsel) * 32 + (colt + bj * HALF + wc * 32) / 32, __builtin_bit_cast(unsigned, v)); }
        }
    }
};
struct EpiF32 {
    static constexpr bool PERM = false, AFTER_DRAIN = false;
    float* C; int ldc; const float* bias;
    __device__ __forceinline__ void operator()(const f32x4 (&acc)[2][2][4][2], const Unit& u, int wr, int wc, int fr, int fq) const {
        const int row0 = u.pm * BM + wr * 64 + fr, col0 = u.pn * BM + wc * 32 + 4 * fq;
        f32x4 bv[2][2];
#pragma unroll
        for (int bj = 0; bj < 2; ++bj)
#pragma unroll
            for (int n = 0; n < 2; ++n) bv[bj][n] = bias ? *(const f32x4*)(bias + col0 + bj * HALF + n * 16) : (f32x4){0.f, 0.f, 0.f, 0.f};
#pragma unroll
        for (int ai = 0; ai < 2; ++ai)
#pragma unroll
            for (int m = 0; m < 4; ++m) { float* rowp = C + (size_t)(row0 + ai * HALF + m * 16) * ldc + col0;
#pragma unroll
                for (int bj = 0; bj < 2; ++bj)
#pragma unroll
                    for (int n = 0; n < 2; ++n) *(f32x4*)(rowp + bj * HALF + n * 16) = acc[ai][bj][m][n] + bv[bj][n]; }
    }
};
template <class Epi, class Sched, bool ALIGN_EPI = false, bool SP2 = false>
__device__ __forceinline__ void gemm_phase(PG8_LAS unsigned char* lds, const Gemm g, const Sched& S, const Epi& E) {
    int tid_ = threadIdx.x; asm volatile("" : "+v"(tid_));
    const int tid = tid_, wid = __builtin_amdgcn_readfirstlane(tid >> 6), lane = tid & 63, wr = wid >> 2, wc = wid & 3, fr = lane & 15, fq = lane >> 4;
    const int K = g.K, nt = K / BK;
    unsigned voffA[2], voffB[2];
#pragma unroll
    for (int i = 0; i < 2; ++i) { int R, C; stage_rc(tid * 16 + i * 8192, R, C); const int Rb = Epi::PERM ? ((R & ~31) + perm32(R & 31)) : R;
        voffA[i] = (unsigned)(R * K + C) * 2u; voffB[i] = (unsigned)(Rb * K + C) * 2u; }
    const size_t kstep = (size_t)(BK * 2);
    const size_t hstep = (size_t)HALF * K * 2;
    const size_t tstep = 2 * hstep;
    const unsigned ldsw = (unsigned)wid * 1024u;
    const int aoff = lds_byte(wr * 64 + fr, fq * 8), boff = lds_byte(wc * 32 + fr, fq * 8);
#define PG8_SA(b, h) (((b) * 2 + (h)) * HTB)
#define PG8_SB(b, h) ((4 + (b) * 2 + (h)) * HTB)
#define PG8_STAGE(bufoff, gbase, voff) do { _Pragma("unroll") for (int _i = 0; _i < 2; ++_i) \
        __builtin_amdgcn_global_load_lds((const unsigned*)((const char*)(gbase) + (voff)[_i]), (PG8_LAS unsigned*)(lds + (bufoff) + ldsw + _i * 8192), 16, 0, 0); } while (0)
#define PG8_LDA(dst, b, h) do { _Pragma("unroll") for (int m = 0; m < 4; ++m) _Pragma("unroll") for (int k = 0; k < 2; ++k) dst[m][k] = *(const PG8_LAS bf16x8*)(lds + PG8_SA(b, h) + aoff + m * 2048 + k * 1024); } while (0)
#define PG8_LDB(dst, b, h) do { _Pragma("unroll") for (int n = 0; n < 2; ++n) _Pragma("unroll") for (int k = 0; k < 2; ++k) dst[n][k] = *(const PG8_LAS bf16x8*)(lds + PG8_SB(b, h) + boff + n * 2048 + k * 1024); } while (0)
#define PG8_MMA(ai, bj, At, Bt) do { __builtin_amdgcn_s_setprio(1); _Pragma("unroll") for (int m = 0; m < 4; ++m) _Pragma("unroll") for (int n = 0; n < 2; ++n) _Pragma("unroll") for (int k = 0; k < 2; ++k) \
        acc[ai][bj][m][n] = __builtin_amdgcn_mfma_f32_16x16x32_bf16(Bt[n][k], At[m][k], acc[ai][bj][m][n], 0, 0, 0); __builtin_amdgcn_s_setprio(0); } while (0)
#define PG8_WAIT_V(n) asm volatile("s_waitcnt vmcnt(" #n ")" ::: "memory")
#define PG8_WAIT_L(n) asm volatile("s_waitcnt lgkmcnt(" #n ")" ::: "memory")
#define PG8_BAR __builtin_amdgcn_s_barrier()
#define PG8_SCHED __builtin_amdgcn_sched_barrier(0)
    Unit cur, nxt; int ui = 0;
    if (!S.next(0, cur)) return;
    f32x4 acc[2][2][4][2];
#pragma unroll
    for (int a = 0; a < 2; ++a)
#pragma unroll
        for (int b = 0; b < 2; ++b)
#pragma unroll
            for (int m = 0; m < 4; ++m)
#pragma unroll
                for (int n = 0; n < 2; ++n) acc[a][b][m][n] = (f32x4){0.f, 0.f, 0.f, 0.f};
    bf16x8 At[4][2], B0[2][2], B1[2][2];
    const char* cA = (const char*)g.A + (size_t)cur.pm * tstep; const char* cB = (const char*)g.Bt + (size_t)cur.pn * tstep;
    S.a_ready(cur);
    if constexpr (SP2) {
        PG8_STAGE(PG8_SB(0, 0), cB, voffB); PG8_STAGE(PG8_SB(0, 1), cB + hstep, voffB); PG8_STAGE(PG8_SA(0, 0), cA, voffA); PG8_STAGE(PG8_SA(0, 1), cA + hstep, voffA);
        if (wr == 1) PG8_BAR;
        PG8_WAIT_V(2); PG8_BAR;
        PG8_STAGE(PG8_SB(1, 0), cB + kstep, voffB); PG8_STAGE(PG8_SA(1, 0), cA + kstep, voffA); PG8_STAGE(PG8_SB(1, 1), cB + hstep + kstep, voffB);
        PG8_WAIT_V(6); PG8_BAR;
    } else {
        PG8_STAGE(PG8_SB(0, 0), cB, voffB); PG8_STAGE(PG8_SA(0, 0), cA, voffA); PG8_STAGE(PG8_SB(0, 1), cB + hstep, voffB); PG8_STAGE(PG8_SA(0, 1), cA + hstep, voffA);
        if (wr == 1) PG8_BAR;
        PG8_WAIT_V(4); PG8_BAR;
        PG8_STAGE(PG8_SB(1, 0), cB + kstep, voffB); PG8_STAGE(PG8_SA(1, 0), cA + kstep, voffA); PG8_STAGE(PG8_SB(1, 1), cB + hstep + kstep, voffB);
        PG8_WAIT_V(6); PG8_BAR;
    }
    for (;;) {
        const bool has_next = S.next(ui + 1, nxt);
        const char* nA = has_next ? (const char*)g.A + (size_t)nxt.pm * tstep : cA; const char* nB = has_next ? (const char*)g.Bt + (size_t)nxt.pn * tstep : cB;
        for (int t = 0; t < nt; t += 2) {
            const bool last = (t == nt - 2);
            const char* a1 = cA + (size_t)(t + 1) * kstep;
            const char* a2 = last ? nA : cA + (size_t)(t + 2) * kstep; const char* b2 = last ? nB : cB + (size_t)(t + 2) * kstep;
            const char* a3 = a2 + kstep; const char* b3 = b2 + kstep;
            if (last && has_next) S.a_ready(nxt);
            if constexpr (SP2) {
            PG8_LDB(B0, 0, 0); PG8_LDB(B1, 0, 1); PG8_SCHED; PG8_LDA(At, 0, 0); PG8_STAGE(PG8_SA(1, 1), a1 + hstep, voffA);
            PG8_WAIT_V(8); PG8_WAIT_L(0); PG8_BAR; PG8_MMA(0, 0, At, B0); PG8_MMA(0, 1, At, B1); PG8_BAR; PG8_SCHED;
            PG8_LDA(At, 0, 1); PG8_STAGE(PG8_SB(0, 0), b2, voffB); PG8_STAGE(PG8_SB(0, 1), b2 + hstep, voffB); PG8_STAGE(PG8_SA(0, 0), a2, voffA);
            PG8_WAIT_V(8); PG8_WAIT_L(0); PG8_BAR; PG8_MMA(1, 0, At, B0); PG8_MMA(1, 1, At, B1); PG8_BAR; PG8_SCHED;
            PG8_LDB(B0, 1, 0); PG8_LDB(B1, 1, 1); PG8_SCHED; PG8_LDA(At, 1, 0); PG8_STAGE(PG8_SA(0, 1), a2 + hstep, voffA);
            PG8_WAIT_V(8); PG8_WAIT_L(0); PG8_BAR; PG8_MMA(0, 0, At, B0); PG8_MMA(0, 1, At, B1); PG8_BAR; PG8_SCHED;
            PG8_LDA(At, 1, 1); PG8_STAGE(PG8_SB(1, 0), b3, voffB); PG8_STAGE(PG8_SB(1, 1), b3 + hstep, voffB); PG8_STAGE(PG8_SA(1, 0), a3, voffA);
            PG8_WAIT_V(8); PG8_WAIT_L(0); PG8_BAR; PG8_MMA(1, 0, At, B0); PG8_MMA(1, 1, At, B1); PG8_BAR; PG8_SCHED;
            } else {
            PG8_LDB(B0, 0, 0); PG8_SCHED; PG8_LDA(At, 0, 0); PG8_STAGE(PG8_SA(1, 1), a1 + hstep, voffA);
            PG8_WAIT_L(8); PG8_BAR; PG8_WAIT_L(0); PG8_MMA(0, 0, At, B0); PG8_BAR; PG8_SCHED;
            PG8_LDB(B1, 0, 1); PG8_STAGE(PG8_SB(0, 0), b2, voffB);
            PG8_BAR; PG8_WAIT_L(0); PG8_MMA(0, 1, At, B1); PG8_BAR;
            PG8_LDA(At, 0, 1); PG8_STAGE(PG8_SA(0, 0), a2, voffA);
            PG8_BAR; PG8_WAIT_L(0); PG8_MMA(1, 0, At, B0); PG8_BAR; PG8_SCHED;
            PG8_STAGE(PG8_SB(0, 1), b2 + hstep, voffB);
            PG8_WAIT_V(6); PG8_BAR; PG8_MMA(1, 1, At, B1); PG8_BAR;
            PG8_LDB(B0, 1, 0); PG8_SCHED; PG8_LDA(At, 1, 0); PG8_STAGE(PG8_SA(0, 1), a2 + hstep, voffA);
            PG8_WAIT_L(8); PG8_BAR; PG8_WAIT_L(0); PG8_MMA(0, 0, At, B0); PG8_BAR; PG8_SCHED;
            PG8_LDB(B1, 1, 1); PG8_STAGE(PG8_SB(1, 0), b3, voffB);
            PG8_BAR; PG8_WAIT_L(0); PG8_MMA(0, 1, At, B1); PG8_BAR;
            PG8_LDA(At, 1, 1); PG8_STAGE(PG8_SA(1, 0), a3, voffA);
            PG8_BAR; PG8_WAIT_L(0); PG8_MMA(1, 0, At, B0); PG8_BAR; PG8_SCHED;
            PG8_STAGE(PG8_SB(1, 1), b3 + hstep, voffB);
            PG8_WAIT_V(6); PG8_BAR; PG8_MMA(1, 1, At, B1); PG8_BAR;
            }
        }
        if constexpr (ALIGN_EPI) { if (wr == 0) PG8_BAR; }
        if constexpr (!Epi::AFTER_DRAIN) { E(acc, cur, wr, wc, fr, fq); S.done(cur); }
        if (!has_next) break;
#pragma unroll
        for (int a = 0; a < 2; ++a)
#pragma unroll
            for (int b = 0; b < 2; ++b)
#pragma unroll
                for (int m = 0; m < 4; ++m)
#pragma unroll
                    for (int n = 0; n < 2; ++n) acc[a][b][m][n] = (f32x4){0.f, 0.f, 0.f, 0.f};
        cur = nxt; cA = nA; cB = nB; ++ui;
        if constexpr (ALIGN_EPI) { if (wr == 1) PG8_BAR; }
    }
    PG8_WAIT_V(0);
    if constexpr (!ALIGN_EPI) { if (wr == 0) PG8_BAR; }
    PG8_BAR;
    if constexpr (Epi::AFTER_DRAIN) { E.fused(acc, cur, wr, wc, fr, fq, lds, wid, lane); S.done(cur); }
#undef PG8_SA
#undef PG8_SB
#undef PG8_STAGE
#undef PG8_LDA
#undef PG8_LDB
#undef PG8_MMA
#undef PG8_WAIT_V
#undef PG8_WAIT_L
#undef PG8_BAR
#undef PG8_SCHED
}
}

#ifndef PG8_SP2
#define PG8_SP2 true
#endif
#ifndef PG8_ALIGN
#define PG8_ALIGN true
#endif

constexpr int NWAVES = 8;
constexpr int BATCH = 4, SEQ = 4096, D = 1024, M = BATCH * SEQ, DEPTH = 4;
constexpr int NQKV = 3 * D, FF = 2816, FF2 = 2 * FF;
constexpr float LN_EPS = 1e-5f, RMS_EPS = 1e-5f;
constexpr float LOG2E = 1.4426950408889634f;
constexpr float QSCALE = 0.125f * LOG2E;
constexpr float ALPHA = 1.6817928305074290861f;
constexpr int PH_PER_LAYER = 9, N_PHASES = DEPTH * PH_PER_LAYER;
#ifndef DIFF_NOSKIP
#define DIFF_NOSKIP 0
#endif
#ifndef NAIVE_NA
#define NAIVE_NA 0
#endif
#ifndef NAIVE_DIFF
#define NAIVE_DIFF 0
#endif
#ifndef MK_ONE_LAUNCH
#define MK_ONE_LAUNCH 1
#endif

constexpr size_t MiB = 1u << 20;
constexpr size_t WS_CTL = 0, CTL_ZERO_BYTES = 1 * MiB;
constexpr size_t WS_WQKV = 2 * MiB, WS_WO = 8 * MiB, WS_WIN = 10 * MiB, WS_WOUT = 21 * MiB;
constexpr size_t WS_XB = 28 * MiB;
constexpr size_t WS_ACT = 60 * MiB;
constexpr size_t WS_H = 148 * MiB;
constexpr size_t WS_Q = 148 * MiB, WS_K = 180 * MiB, WS_V = 212 * MiB, WS_O = 244 * MiB;
constexpr size_t WS_Y = 276 * MiB;
constexpr size_t WS_END = 340 * MiB;
constexpr int CW_BAR = 4096, CW_NRM = 1024, CW_QUE = 2048;

constexpr int RING_OFF = 0, RING_BYTES = 131072;
constexpr int LDSCTL_OFF = RING_BYTES, MISC_OFF = LDSCTL_OFF + 320;
constexpr int LDS_BYTES = 147456;

#define GAS __attribute__((address_space(1)))
#define LAS __attribute__((address_space(3)))
typedef unsigned short bf16;
typedef unsigned v4u __attribute__((ext_vector_type(4)));
typedef float f32x4 __attribute__((ext_vector_type(4)));
typedef short bf16x8 __attribute__((ext_vector_type(8)));
typedef GAS unsigned gu32;
typedef GAS unsigned long long gu64;
#define RLX_AGENT __ATOMIC_RELAXED, __HIP_MEMORY_SCOPE_AGENT
#define LDS_WAIT() asm volatile("s_waitcnt lgkmcnt(0)" ::: "memory")
#define VM_WAIT() asm volatile("s_waitcnt vmcnt(0)" ::: "memory")
__device__ __forceinline__ unsigned long long rt() { return __builtin_amdgcn_s_memrealtime(); }
__device__ __forceinline__ unsigned f2bf(float f) { unsigned u = __builtin_bit_cast(unsigned, f); return (u + 0x7fffu + ((u >> 16) & 1u)) >> 16; }
__device__ __forceinline__ unsigned pk2(float lo, float hi) { return f2bf(lo) | (f2bf(hi) << 16); }

#define XB_TMO      128
#define XB_XCNT(j)  (256  + 64 * (j))
#define XB_XSUB(j)  (1280 + 64 * (j))
#define XB_XGEN(j)  (2304 + 64 * (j))
#define XB_TOP      3328
#define XB_TOPGEN   3392
#define XCD_BAR_WORDS 3456
#define XB_SPIN_CAP (1u << 18)

__device__ __forceinline__ unsigned xb_ld(unsigned* p)              { return __hip_atomic_load(p, __ATOMIC_RELAXED, __HIP_MEMORY_SCOPE_AGENT); }
__device__ __forceinline__ unsigned xb_add(unsigned* p, unsigned v) { return __hip_atomic_fetch_add(p, v, __ATOMIC_RELAXED, __HIP_MEMORY_SCOPE_AGENT); }
__device__ __forceinline__ unsigned xb_xcc_id() { return (unsigned)__builtin_amdgcn_s_getreg((3 << 11) | 20) & 0xFu; }
#define XB_SPIN(cond, bar) do { unsigned _sp = 0; while (cond) { __builtin_amdgcn_s_sleep(1); \
    if ((++_sp & 255u) == 0u) { if (xb_ld(&(bar)[XB_TMO])) break; if (_sp > XB_SPIN_CAP) { atomicAdd(&(bar)[XB_TMO], 1u); break; } } } } while (0)

struct XcdBarrier {
    unsigned* bar; unsigned x;
    volatile LAS unsigned* st;
};

__device__ __forceinline__ XcdBarrier xcd_barrier_post(unsigned* bar, volatile LAS unsigned* st) {
    XcdBarrier b; b.bar = bar; b.x = xb_xcc_id(); b.st = st;
    if (threadIdx.x == 0) (void)xb_add(&bar[XB_XCNT(b.x)], 1u);
    return b;
}
__device__ __forceinline__ void xcd_barrier_complete(unsigned* bar, unsigned x, unsigned& nloc, unsigned& nx) {
    const unsigned G = gridDim.x * gridDim.y * gridDim.z;
    unsigned sum, cnt, mine, sp = 0u;
    for (;;) {
        sum = 0u; cnt = 0u; mine = 0u;
#pragma unroll
        for (unsigned j = 0; j < 16; ++j) { const unsigned c = xb_ld(&bar[XB_XCNT(j)]); sum += c; cnt += (c > 0u) ? 1u : 0u; mine = (j == x) ? c : mine; }
        if (sum == G) break;
        __builtin_amdgcn_s_sleep(1);
        if ((++sp & 255u) == 0u) { if (xb_ld(&bar[XB_TMO])) break; if (sp > XB_SPIN_CAP) { atomicAdd(&bar[XB_TMO], 1u); break; } }
    }
    nloc = mine > 0u ? mine : 1u; nx = cnt > 0u ? cnt : 1u;
}

__device__ __forceinline__ void xcd_barrier(const XcdBarrier& b) {
    asm volatile("s_waitcnt vmcnt(0)" ::: "memory");
    __syncthreads();
    if (threadIdx.x == 0) {
        unsigned* bar = b.bar;
        __builtin_amdgcn_s_waitcnt(0);
        unsigned nloc = b.st[0], nx = b.st[1];
        if (nloc == 0u) { xcd_barrier_complete(bar, b.x, nloc, nx); b.st[0] = nloc; b.st[1] = nx; }
        const unsigned old = xb_add(&bar[XB_XSUB(b.x)], 1u);
        const unsigned gen = old / nloc;
        if (old + 1u == (gen + 1u) * nloc) {
            __builtin_amdgcn_fence(__ATOMIC_RELEASE, "agent");
            asm volatile("s_waitcnt vmcnt(0)" ::: "memory");
            const unsigned og = xb_add(&bar[XB_TOP], 1u);
            const unsigned tg = og / nx;
            if (og + 1u == (tg + 1u) * nx) xb_add(&bar[XB_TOPGEN], 1u);
            else XB_SPIN(xb_ld(&bar[XB_TOPGEN]) == tg, bar);
            __builtin_amdgcn_fence(__ATOMIC_ACQUIRE, "agent");
            xb_add(&bar[XB_XGEN(b.x)], 1u);
            asm volatile("s_waitcnt vmcnt(0)" ::: "memory");
        } else {
            XB_SPIN(xb_ld(&bar[XB_XGEN(b.x)]) == gen, bar);
            __builtin_amdgcn_fence(__ATOMIC_ACQUIRE, "agent");
            asm volatile("s_waitcnt vmcnt(0)" ::: "memory");
        }
    }
    __syncthreads();
}


struct Args { const float* in[18]; float* out; unsigned char* ws; int ph_lo, ph_hi; };

struct Frame {
    LAS unsigned char* lds;
    volatile LAS unsigned* MISC;
    gu32* ctl;
    int tid, lane, wave, G, vcu;
};

__device__ __forceinline__ float wave_sum(float v) {
#pragma unroll
    for (int o = 1; o < 64; o <<= 1) v += __shfl_xor(v, o);
    return v;
}
__device__ __forceinline__ float wave_max(float v) {
#pragma unroll
    for (int o = 1; o < 64; o <<= 1) v = fmaxf(v, __shfl_xor(v, o));
    return v;
}
__device__ __forceinline__ float bf2f(unsigned short u) { return __builtin_bit_cast(float, (unsigned)u << 16); }

__device__ __forceinline__ void p0_transpose_item(const float* W, int K, int N, bf16* WT, int row_off, LAS float* scr, int item, int lane) {
    const int nblk = N / 32, kb = item / nblk, nb = item % nblk, k0 = 64 * kb, n0 = 32 * nb;
#pragma unroll 8
    for (int i = 0; i < 32; ++i) { const int kk = 2 * i + (lane >> 5); scr[kk * 33 + (lane & 31)] = W[(size_t)(k0 + kk) * N + n0 + (lane & 31)]; }
    LDS_WAIT(); asm volatile("" ::: "memory");
    const int c = lane & 7;
#pragma unroll
    for (int j = 0; j < 4; ++j) { const int n = (lane >> 3) + 8 * j; const LAS float* s = scr + (8 * c) * 33 + n;
        v4u o; o.x = pk2(s[0 * 33], s[1 * 33]); o.y = pk2(s[2 * 33], s[3 * 33]); o.z = pk2(s[4 * 33], s[5 * 33]); o.w = pk2(s[6 * 33], s[7 * 33]);
        *(GAS v4u*)(WT + (size_t)(row_off + n0 + n) * K + k0 + 8 * c) = o; }
    LDS_WAIT(); asm volatile("" ::: "memory");
}

__device__ __forceinline__ void ph_convert(const Args& a, Frame& F, int L) {
    LAS float* scr = (LAS float*)(F.lds + RING_OFF + F.wave * 16384);
    const int gw = F.vcu * NWAVES + F.wave, NGW = F.G * NWAVES;
    const int j = L >> 1;
    const float* wqkv = ((L & 1) ? a.in[5] : a.in[1]) + (size_t)j * D * NQKV;
    const float* wo = ((L & 1) ? a.in[8] : a.in[2]) + (size_t)j * D * D;
    const float* win = a.in[10] + (size_t)L * D * FF2;
    const float* wout = a.in[14] + (size_t)L * FF * D;
    bf16* WQKV = (bf16*)(a.ws + WS_WQKV); bf16* WO = (bf16*)(a.ws + WS_WO); bf16* WIN = (bf16*)(a.ws + WS_WIN); bf16* WOUT = (bf16*)(a.ws + WS_WOUT);
    constexpr int I_QKV = (D / 64) * (NQKV / 32), I_O = (D / 64) * (D / 32), I_IN = (D / 64) * (FF2 / 32), I_OUT = (FF / 64) * (D / 32);
    constexpr int NITEMS = I_QKV + I_O + I_IN + I_OUT;
    for (int it = gw; it < NITEMS; it += NGW) {
        int r = it;
        if (r < I_QKV) { p0_transpose_item(wqkv, D, NQKV, WQKV, 0, scr, r, F.lane); continue; } r -= I_QKV;
        if (r < I_O) { p0_transpose_item(wo, D, D, WO, 0, scr, r, F.lane); continue; } r -= I_O;
        if (r < I_IN) { p0_transpose_item(win, D, FF2, WIN, 0, scr, r, F.lane); continue; } r -= I_IN;
        p0_transpose_item(wout, FF, D, WOUT, 0, scr, r, F.lane);
    }
    if (L == 0) {
        bf16* XB = (bf16*)(a.ws + WS_XB);
        for (int m = gw; m < M; m += NGW) {
            const GAS f32x4* xr = (const GAS f32x4*)(a.in[0] + (size_t)m * D) + F.lane;
            GAS unsigned long long* o8 = (GAS unsigned long long*)(XB + (size_t)m * D) + F.lane;
#pragma unroll
            for (int q = 0; q < 4; ++q) { const f32x4 v = xr[64 * q]; o8[64 * q] = (unsigned long long)pk2(v.x, v.y) | ((unsigned long long)pk2(v.z, v.w) << 32); }
        }
    }
}

__device__ __forceinline__ void ph_ln(const Args& a, Frame& F, int L, int which) {
    const int gw = F.vcu * NWAVES + F.wave, NGW = F.G * NWAVES;
    const float* xin = (L == 0 && which == 0) ? a.in[0] : a.out;
    const float* Y = (const float*)(a.ws + WS_Y);
    const float* g = a.in[16] + (size_t)(L * 2 + which) * D; const float* bb = a.in[17] + (size_t)(L * 2 + which) * D;
    bf16* XB = (bf16*)(a.ws + WS_XB);
    f32x4 gv[4], bv[4];
#pragma unroll
    for (int q = 0; q < 4; ++q) { gv[q] = ((const GAS f32x4*)g)[F.lane + 64 * q]; bv[q] = ((const GAS f32x4*)bb)[F.lane + 64 * q]; }
    for (int m = gw; m < M; m += NGW) {
        const GAS f32x4* xr = (const GAS f32x4*)(xin + (size_t)m * D) + F.lane;
        const GAS f32x4* yr = (const GAS f32x4*)(Y + (size_t)m * D) + F.lane;
        f32x4 v[4]; float s = 0.f;
#pragma unroll
        for (int q = 0; q < 4; ++q) { v[q] = xr[64 * q] * ALPHA + yr[64 * q]; s += (v[q].x + v[q].y) + (v[q].z + v[q].w); }
        const float mean = wave_sum(s) * (1.f / D); float s2 = 0.f;
#pragma unroll
        for (int q = 0; q < 4; ++q) { v[q] = v[q] - mean; s2 += (v[q].x * v[q].x + v[q].y * v[q].y) + (v[q].z * v[q].z + v[q].w * v[q].w); }
        const float rstd = 1.f / sqrtf(wave_sum(s2) * (1.f / D) + LN_EPS);
        GAS f32x4* orow = (GAS f32x4*)(a.out + (size_t)m * D) + F.lane;
        GAS unsigned long long* o8 = (GAS unsigned long long*)(XB + (size_t)m * D) + F.lane;
#pragma unroll
        for (int q = 0; q < 4; ++q) { const f32x4 o = v[q] * rstd * gv[q] + bv[q]; orow[64 * q] = o;
            o8[64 * q] = (unsigned long long)pk2(o.x, o.y) | ((unsigned long long)pk2(o.z, o.w) << 32); }
    }
}

__device__ __forceinline__ void ph_conv(const Args& a, Frame& F, int L) {
    const bf16* H = (const bf16*)(a.ws + WS_H); bf16* ACT = (bf16*)(a.ws + WS_ACT);
    const float* cw = a.in[12] + (size_t)L * 3 * FF2; const float* cb = a.in[13] + (size_t)L * FF2;
    constexpr int CPR = FF / 8;
    const long total = (long)M * CPR, nthr = (long)F.G * NWAVES * 64;
    for (long idx = (long)F.vcu * NWAVES * 64 + F.tid; idx < total; idx += nthr) {
        const int row = (int)(idx / CPR), ch = (int)(idx % CPR), col = ch * 8, t = row % SEQ;
        float uo[8], go[8];
#pragma unroll
        for (int e = 0; e < 8; ++e) { uo[e] = cb[col + e]; go[e] = cb[FF + col + e]; }
#pragma unroll
        for (int k = 0; k < 3; ++k) {
            const int tt = t + k - 1; if (tt < 0 || tt >= SEQ) continue;
            const bf16* hp = H + (size_t)(row + k - 1) * FF2 + col;
            const bf16x8 hu = *(const bf16x8*)hp, hg = *(const bf16x8*)(hp + FF);
#pragma unroll
            for (int e = 0; e < 8; ++e) { uo[e] += cw[(size_t)k * FF2 + col + e] * bf2f((unsigned short)hu[e]); go[e] += cw[(size_t)k * FF2 + FF + col + e] * bf2f((unsigned short)hg[e]); }
        }
        v4u o; float r[8];
#pragma unroll
        for (int e = 0; e < 8; ++e) r[e] = uo[e] * (0.5f * go[e] * (1.0f + erff(go[e] * 0.70710678118654752f)));
        o.x = pk2(r[0], r[1]); o.y = pk2(r[2], r[3]); o.z = pk2(r[4], r[5]); o.w = pk2(r[6], r[7]);
        *(GAS v4u*)(ACT + (size_t)row * FF + col) = o;
    }
}

__device__ __forceinline__ void diff_scores(const bf16* kp, const LAS float* qs, float& s1, float& s2) {
    s1 = 0.f; s2 = 0.f;
    asm volatile("" ::: "memory");
#pragma unroll 4
    for (int c = 0; c < 16; ++c) {
        asm volatile("" ::: "memory");
        const bf16x8 kv = *(const bf16x8*)(kp + c * 8);
        const f32x4 q0 = *(const LAS f32x4*)(qs + c * 8), q1 = *(const LAS f32x4*)(qs + c * 8 + 4);
        float acc = q0.x * bf2f((unsigned short)kv[0]) + q0.y * bf2f((unsigned short)kv[1]) + q0.z * bf2f((unsigned short)kv[2]) + q0.w * bf2f((unsigned short)kv[3])
                  + q1.x * bf2f((unsigned short)kv[4]) + q1.y * bf2f((unsigned short)kv[5]) + q1.z * bf2f((unsigned short)kv[6]) + q1.w * bf2f((unsigned short)kv[7]);
        if (c < 8) s1 += acc; else s2 += acc;
    }
}
__device__ __forceinline__ void naive_diff_attn(const Args& a, Frame& F, int L) {
    const int gw = F.vcu * NWAVES + F.wave, NGW = F.G * NWAVES, lane = F.lane;
    const int j = L >> 1;
    const float lam_init = (L == 0) ? 0.2f : 0.47071301834358416f;
    const float* lf = a.in[3] + (size_t)j * 4 * 64;
    const float lam = expf(wave_sum(lf[lane] * lf[64 + lane])) - expf(wave_sum(lf[128 + lane] * lf[192 + lane])) + lam_init;
    const float* sg = a.in[4] + (size_t)j * 128;
    const float g0 = sg[lane], g1 = sg[64 + lane];
    const bf16* Q = (const bf16*)(a.ws + WS_Q); const bf16* K = (const bf16*)(a.ws + WS_K); const bf16* V = (const bf16*)(a.ws + WS_V); bf16* O = (bf16*)(a.ws + WS_O);
    LAS float* qs = (LAS float*)(F.lds + RING_OFF) + F.wave * 128;
    for (int task = gw; task < M * 8; task += NGW) {
        const int h = task & 7, row = task >> 3, b = row / SEQ, t = row % SEQ;
        const bf16* qp = Q + (size_t)row * D + h * 128;
        qs[lane] = bf2f(qp[lane]); qs[64 + lane] = bf2f(qp[64 + lane]);
        LDS_WAIT(); asm volatile("" ::: "memory");
        const float c2 = exp2f(-(float)(h + 1)) * LOG2E;
        const bf16* Kb = K + (size_t)b * SEQ * D + h * 128; const bf16* Vb = V + (size_t)b * SEQ * D + h * 128;
        float m1 = -1e30f, l1 = 0.f, m2 = -1e30f, l2 = 0.f;
        for (int tile = 0; tile < SEQ / 64; ++tile) {
            const int s = tile * 64 + lane; float s1, s2; diff_scores(Kb + (size_t)s * D, qs, s1, s2);
            const float pen = c2 * fabsf((float)(t - s)); s1 -= pen; s2 -= pen;
            float mn = fmaxf(m1, s1); l1 = l1 * exp2f(m1 - mn) + exp2f(s1 - mn); m1 = mn;
            mn = fmaxf(m2, s2); l2 = l2 * exp2f(m2 - mn) + exp2f(s2 - mn); m2 = mn;
        }
        const float M1 = wave_max(m1), M2 = wave_max(m2);
        const float i1 = 1.f / wave_sum(l1 * exp2f(m1 - M1)), i2 = lam / wave_sum(l2 * exp2f(m2 - M2));
        float o0 = 0.f, o1 = 0.f;
        for (int tile = 0; tile < SEQ / 64; ++tile) {
            const int s = tile * 64 + lane; float s1, s2; diff_scores(Kb + (size_t)s * D, qs, s1, s2);
            const float pen = c2 * fabsf((float)(t - s)); s1 -= pen; s2 -= pen;
            const float av = exp2f(s1 - M1) * i1 - exp2f(s2 - M2) * i2;
            const bf16* vp = Vb + (size_t)(tile * 64) * D + lane;
#pragma unroll 8
            for (int jj = 0; jj < 64; ++jj) { const float aj = __shfl(av, jj); o0 += aj * bf2f(vp[(size_t)jj * D]); o1 += aj * bf2f(vp[(size_t)jj * D + 64]); }
        }
        const float ms = wave_sum(o0 * o0 + o1 * o1) * (1.f / 128.f);
        const float r = (1.f / sqrtf(ms + RMS_EPS)) * (1.f - lam_init);
        bf16* op = O + (size_t)row * D + h * 128;
        op[lane] = (bf16)f2bf(o0 * r * g0); op[64 + lane] = (bf16)f2bf(o1 * r * g1);
        asm volatile("" ::: "memory");
    }
}

namespace da {
typedef short bf16x8 __attribute__((ext_vector_type(8)));
typedef short s16x4 __attribute__((ext_vector_type(4)));
typedef float f32x16 __attribute__((ext_vector_type(16)));
typedef float f32x4v __attribute__((ext_vector_type(4)));
typedef unsigned u32x2v __attribute__((ext_vector_type(2)));
constexpr int SLOT = 32768, EXS = 129;
constexpr float THR = 6.0f;
__device__ __forceinline__ s16x4 vtr(const LAS unsigned char* p) { return __builtin_bit_cast(s16x4, __builtin_amdgcn_ds_read_tr16_b64_v4i16((LAS s16x4*)p)); }
__device__ __forceinline__ unsigned cvtpk(float lo, float hi) { typedef float f2 __attribute__((ext_vector_type(2))); typedef __bf16 b2 __attribute__((ext_vector_type(2))); f2 v = {lo, hi}; b2 b = __builtin_convertvector(v, b2); return __builtin_bit_cast(unsigned, b); }
__device__ __forceinline__ bf16x8 pack8(const f32x16& p, int base) {
    typedef unsigned u4 __attribute__((ext_vector_type(4)));
    u4 w; w.x = cvtpk(p[base], p[base + 1]); w.y = cvtpk(p[base + 2], p[base + 3]); w.z = cvtpk(p[base + 4], p[base + 5]); w.w = cvtpk(p[base + 6], p[base + 7]);
    return __builtin_bit_cast(bf16x8, w);
}
__device__ __forceinline__ void glds16(const void* gsrc, unsigned lds_dst) { unsigned keep;
    asm volatile("s_mov_b32 %0, m0\n\ts_mov_b32 m0, %2\n\ts_nop 0\n\tglobal_load_lds_dwordx4 %1, off\n\ts_mov_b32 m0, %0" : "=&s"(keep) : "v"(gsrc), "s"(lds_dst) : "memory"); }
__device__ __forceinline__ unsigned lds_addr(const LAS unsigned char* p) { return (unsigned)(uintptr_t)p; }
__device__ __forceinline__ void issue_tile(const bf16* Kh, const bf16* Vh, int tile, LAS unsigned char* slot, int wave, int lane) {
#pragma unroll
    for (int i = 0; i < 4; ++i) {
        const int p = wave + 8 * i; const bf16* src;
        if (i < 2) src = Kh + (size_t)(tile * 64 + lane) * D + i * 64 + wave * 8;
        else { const int pv = p - 16, db = pv >> 2, kg = pv & 3; src = Vh + (size_t)(tile * 64 + 16 * kg + (lane >> 2)) * D + 32 * db + (lane & 3) * 8; }
        glds16(src, (unsigned)__builtin_amdgcn_readfirstlane(lds_addr(slot + p * 1024)));
    }
}
__device__ __forceinline__ int tile_at(int s, int td0, int nL, int nR) {
    if (s < 2) return td0 + s;
    const int k = s - 2, mn = nL < nR ? nL : nR;
    if (k < 2 * mn) return (k & 1) ? td0 + 2 + (k >> 1) : td0 - 1 - (k >> 1);
    const int e = k - 2 * mn;
    return nL > nR ? td0 - 1 - mn - e : td0 + 2 + mn + e;
}
__device__ __forceinline__ void score_tile(f32x16& p0, f32x16& p1, const LAS unsigned char* kb, const bf16x8 (&qr)[4], float c2, float dq, float mref, int side) {
    if (side != 0) {
        const float cs = side < 0 ? c2 : -c2, base = -cs * dq - mref;
#pragma unroll
        for (int r = 0; r < 16; ++r) { const float kc = (float)((r & 3) + 8 * (r >> 2)); p0[r] = __builtin_fmaf(cs, kc, base); p1[r] = __builtin_fmaf(cs, kc + 32.f, base); }
    } else {
#pragma unroll
        for (int r = 0; r < 16; ++r) { p0[r] = 0.f; p1[r] = 0.f; }
    }
#pragma unroll
    for (int d0 = 0; d0 < 4; ++d0) {
        const bf16x8 b0 = *(const LAS bf16x8*)(kb + d0 * 2048), b1 = *(const LAS bf16x8*)(kb + d0 * 2048 + 512);
        p0 = __builtin_amdgcn_mfma_f32_32x32x16_bf16(b0, qr[d0], p0, 0, 0, 0);
        p1 = __builtin_amdgcn_mfma_f32_32x32x16_bf16(b1, qr[d0], p1, 0, 0, 0);
    }
    if (side == 0) {
#pragma unroll
        for (int r = 0; r < 16; ++r) { const float kc = (float)((r & 3) + 8 * (r >> 2));
            p0[r] = __builtin_fmaf(-c2, __builtin_fabsf(dq - kc), p0[r]) - mref; p1[r] = __builtin_fmaf(-c2, __builtin_fabsf(dq - kc - 32.f), p1[r]) - mref; }
    }
}
constexpr int NSLOT = 4;
constexpr float PS_LIM = 256.f, GROW = 2.f;
__device__ __forceinline__ void unit(int b, int h, int qblk, int t_lo, int t_hi, const bf16* Q, const bf16* K, const bf16* V, bf16* O, LAS unsigned char* ring, float lam, float one_m_li, const float* sg, int wave, int lane) {
    const int r32 = lane & 31, hi = lane >> 5, c = wave >> 2, qs = wave & 3;
    const size_t rowbase = (size_t)b * SEQ; const int q0 = qblk * 128 + 32 * qs;
    const bf16* Kh = K + rowbase * D + h * 128; const bf16* Vh = V + rowbase * D + h * 128;
    const bf16* Qw = Q + (rowbase + q0 + r32) * D + h * 128 + c * 64 + hi * 8;
    bf16x8 qr[4];
#pragma unroll
    for (int d0 = 0; d0 < 4; ++d0) qr[d0] = *(const bf16x8*)(Qw + d0 * 16);
    const int td0 = 2 * qblk, nL = td0 - t_lo, nR = t_hi - (td0 + 1), n = nL + nR + 2, tdw = td0 + (qs >> 1);
    issue_tile(Kh, Vh, tile_at(0, td0, nL, nR), ring, wave, lane);
    issue_tile(Kh, Vh, tile_at(1, td0, nL, nR), ring + SLOT, wave, lane);
    f32x16 o[4];
#pragma unroll
    for (int db = 0; db < 4; ++db)
#pragma unroll
        for (int r = 0; r < 16; ++r) o[db][r] = 0.f;
    float m = -1e30f, l = 0.f;
    const float c2 = exp2f(-(float)(h + 1)) * LOG2E;
    const float qpos = (float)(q0 + r32 - 4 * hi);
    bf16x8 pb[4];
#pragma unroll
    for (int k = 0; k < 4; ++k) pb[k] = (bf16x8){0, 0, 0, 0, 0, 0, 0, 0};
    const int voff = 16384 + (4 * hi + ((lane & 15) >> 2)) * 64 + ((lane >> 4) & 1) * 32 + (lane & 3) * 8;
#define DA_SB() __builtin_amdgcn_sched_barrier(0)
#define DA_LOADV8(dst, vb, dbb) do { _Pragma("unroll") for (int d2 = 0; d2 < 2; ++d2) _Pragma("unroll") for (int ks = 0; ks < 4; ++ks) { \
        const s16x4 lo_ = vtr((vb) + ((dbb) + d2) * 4096 + ks * 1024), hh_ = vtr((vb) + ((dbb) + d2) * 4096 + ks * 1024 + 512); \
        dst[d2 * 4 + ks] = (bf16x8){lo_[0], lo_[1], lo_[2], lo_[3], hh_[0], hh_[1], hh_[2], hh_[3]}; } } while (0)
#define DA_PV8(src, dbb) do { _Pragma("unroll") for (int d2 = 0; d2 < 2; ++d2) _Pragma("unroll") for (int ks = 0; ks < 4; ++ks) \
        o[(dbb) + d2] = __builtin_amdgcn_mfma_f32_32x32x16_bf16(src[d2 * 4 + ks], pb[ks], o[(dbb) + d2], 0, 0, 0); } while (0)
    for (int i = 0; i <= n; ++i) {
        if (i + 1 < n) asm volatile("s_waitcnt vmcnt(4) lgkmcnt(0)\n\ts_barrier" ::: "memory");
        else asm volatile("s_waitcnt vmcnt(0) lgkmcnt(0)\n\ts_barrier" ::: "memory");
        if (i + 2 < n) issue_tile(Kh, Vh, tile_at(i + 2, td0, nL, nR), ring + ((i + 2) & 3) * SLOT, wave, lane);
        bf16x8 vfa[8], vfb[8];
        if (c == 1 && i >= 1) {
            const LAS unsigned char* vb = ring + ((i - 1) & 3) * SLOT + voff;
            DA_LOADV8(vfa, vb, 0); DA_LOADV8(vfb, vb, 2); DA_SB();
            DA_PV8(vfa, 0); DA_PV8(vfb, 2); DA_SB();
        }
        if (i < n) {
            const int t = tile_at(i, td0, nL, nR);
            const LAS unsigned char* slot = ring + (i & 3) * SLOT;
            const LAS unsigned char* kb = slot + c * 8192 + hi * 1024 + r32 * 16;
            const int side = t < tdw ? -1 : (t > tdw ? 1 : 0);
            const float dq = qpos - (float)(64 * t);
            f32x16 p0, p1;
            score_tile(p0, p1, kb, qr, c2, dq, m, side);
            if (c == 0) { DA_SB(); DA_LOADV8(vfa, slot + voff, 0); DA_SB(); }
            float ps = 0.f;
#pragma unroll
            for (int r = 0; r < 16; ++r) { p0[r] = __builtin_amdgcn_exp2f(p0[r]); p1[r] = __builtin_amdgcn_exp2f(p1[r]); ps += p0[r] + p1[r]; }
            if (__any(!(ps <= PS_LIM))) {
                score_tile(p0, p1, kb, qr, c2, dq, 0.f, side);
                float rm = -1e30f;
#pragma unroll
                for (int r = 0; r < 16; ++r) rm = __builtin_fmaxf(rm, __builtin_fmaxf(p0[r], p1[r]));
                rm = __builtin_fmaxf(rm, __shfl_xor(rm, 32));
                const bool grow = rm > m + GROW;
                const float mn = grow ? rm : m; const float al = __builtin_amdgcn_exp2f(m - mn); l *= al; m = mn;
#pragma unroll
                for (int db = 0; db < 4; ++db)
#pragma unroll
                    for (int r = 0; r < 16; ++r) o[db][r] *= al;
                ps = 0.f;
#pragma unroll
                for (int r = 0; r < 16; ++r) { p0[r] = __builtin_amdgcn_exp2f(p0[r] - m); p1[r] = __builtin_amdgcn_exp2f(p1[r] - m); ps += p0[r] + p1[r]; }
            }
            l += ps;
            pb[0] = pack8(p0, 0); pb[1] = pack8(p0, 8); pb[2] = pack8(p1, 0); pb[3] = pack8(p1, 8);
            if (c == 0) { DA_SB(); DA_LOADV8(vfb, slot + voff, 2); DA_SB(); DA_PV8(vfa, 0); DA_PV8(vfb, 2); DA_SB(); }
        }
    }
#undef DA_SB
#undef DA_LOADV8
#undef DA_PV8
    l += __shfl_xor(l, 32); const float inv = 1.f / l;
    __syncthreads();
    LAS float* ex = (LAS float*)ring + (qs * 32 + r32) * EXS;
    if (c == 1) { const float f = inv * lam;
#pragma unroll
        for (int db = 0; db < 4; ++db)
#pragma unroll
            for (int r = 0; r < 16; ++r) ex[32 * db + (r & 3) + 8 * (r >> 2) + 4 * hi] = o[db][r] * f; }
    __syncthreads();
    if (c == 0) {
        float ss = 0.f;
#pragma unroll
        for (int db = 0; db < 4; ++db)
#pragma unroll
            for (int r = 0; r < 16; ++r) { const float v = o[db][r] * inv - ex[32 * db + (r & 3) + 8 * (r >> 2) + 4 * hi]; o[db][r] = v; ss += v * v; }
        ss += __shfl_xor(ss, 32);
        const float rn = (1.f / sqrtf(ss * (1.f / 128.f) + RMS_EPS)) * one_m_li;
        bf16* orow = O + (rowbase + q0 + r32) * D + h * 128;
#pragma unroll
        for (int db = 0; db < 4; ++db)
#pragma unroll
            for (int g4 = 0; g4 < 4; ++g4) { const int d = 32 * db + 8 * g4 + 4 * hi; const f32x4v gg = *(const f32x4v*)(sg + d);
                u32x2v w; w.x = cvtpk(o[db][4 * g4] * rn * gg.x, o[db][4 * g4 + 1] * rn * gg.y); w.y = cvtpk(o[db][4 * g4 + 2] * rn * gg.z, o[db][4 * g4 + 3] * rn * gg.w);
                *(u32x2v*)(orow + d) = w; }
    }
    __syncthreads();
}
}
__device__ __forceinline__ void ph_diff_attn(const Args& a, Frame& F, int L) {
    const int j = L >> 1, lane = F.lane;
    const float lam_init = (L == 0) ? 0.2f : 0.47071301834358416f;
    const float* lf = a.in[3] + (size_t)j * 4 * 64;
    const float lam = expf(wave_sum(lf[lane] * lf[64 + lane])) - expf(wave_sum(lf[128 + lane] * lf[192 + lane])) + lam_init;
    const float* sg = a.in[4] + (size_t)j * 128;
    const bf16* Q = (const bf16*)(a.ws + WS_Q); const bf16* K = (const bf16*)(a.ws + WS_K); const bf16* V = (const bf16*)(a.ws + WS_V); bf16* O = (bf16*)(a.ws + WS_O);
    const gu32* nrm = F.ctl + CW_NRM + j * 256;
    const int nunits = BATCH * 8 * (SEQ / 128), rounds = (nunits + F.G - 1) / F.G;
    volatile LAS unsigned* qslot = F.MISC + 16;
    for (int i = 0;; ++i) {
        int b, h, qblk;
        if (F.G == 256) {
            const int x = F.vcu >> 5, hs = x & 1;
            __syncthreads();
            if (F.tid == 0) qslot[0] = __hip_atomic_fetch_add(F.ctl + CW_QUE + (j * 8 + x) * 64, 1u, RLX_AGENT);
            __syncthreads();
            const int k = __builtin_amdgcn_readfirstlane((int)qslot[0]);
            if (k >= 128) break;
            const int hi4 = k >> 5; b = x >> 1; qblk = k & 31;
            h = (hi4 == 0) ? (hs ? 6 : 7) : (hi4 == 1) ? (hs ? 5 : 4) : (hi4 == 2) ? (hs ? 2 : 3) : (hs ? 1 : 0);
        } else { if (i >= rounds) break; const int u = F.vcu + i * F.G; if (u >= nunits) break; const int bh = u >> 5; b = bh >> 3; h = bh & 7; qblk = u & 31; }
        float Bm = 0.f;
#pragma unroll
        for (int c = 0; c < 2; ++c) {
            const float q2 = __uint_as_float(__hip_atomic_load(nrm + (b * 2 + 0) * 32 + 4 * h + 2 * c, RLX_AGENT)) + __uint_as_float(__hip_atomic_load(nrm + (b * 2 + 0) * 32 + 4 * h + 2 * c + 1, RLX_AGENT));
            const float k2 = __uint_as_float(__hip_atomic_load(nrm + (b * 2 + 1) * 32 + 4 * h + 2 * c, RLX_AGENT)) + __uint_as_float(__hip_atomic_load(nrm + (b * 2 + 1) * 32 + 4 * h + 2 * c + 1, RLX_AGENT));
            Bm = fmaxf(Bm, sqrtf(q2 * k2));
        }
        Bm = __builtin_amdgcn_readfirstlane(Bm) * 1.02f;
        const float c2 = exp2f(-(float)(h + 1)) * LOG2E, dmax = (2.f * Bm + 152.f) / c2;
        const int Q0 = 128 * qblk;
        int t_lo = (int)ceilf(((float)(Q0 - 63) - dmax) * (1.f / 64.f)), t_hi = (int)floorf(((float)(Q0 + 127) + dmax) * (1.f / 64.f));
        t_lo = t_lo < 0 ? 0 : (t_lo > 2 * qblk ? 2 * qblk : t_lo); t_hi = t_hi > SEQ / 64 - 1 ? SEQ / 64 - 1 : (t_hi < 2 * qblk + 1 ? 2 * qblk + 1 : t_hi);
#if DIFF_NOSKIP
        t_lo = 0; t_hi = SEQ / 64 - 1;
#endif
        da::unit(b, h, qblk, t_lo, t_hi, Q, K, V, O, F.lds + RING_OFF, lam, 1.f - lam_init, sg, F.wave, lane);
    }
}

namespace na {
using da::bf16x8; using da::s16x4; using da::f32x16; using da::f32x4v; using da::u32x2v;
constexpr int TAB_OFF = MISC_OFF + 512, TAB_PAD = 64, NTAB = 15 * 31;
__device__ __forceinline__ void issue_v(const bf16* Vh, int kr, LAS unsigned char* slot, int lane) {
#pragma unroll
    for (int p = 0; p < 8; ++p) { const int db = p >> 2, kg = p & 3;
        const bf16* src = Vh + (size_t)(kr * 64 + 16 * kg + (lane >> 2)) * D + 32 * db + (lane & 3) * 8;
        da::glds16(src, (unsigned)__builtin_amdgcn_readfirstlane(da::lds_addr(slot + p * 1024))); }
}
__device__ __forceinline__ void load_k(bf16x8 (&kf)[8], const bf16* Kh, int kr, int r32, int hi) {
#pragma unroll
    for (int d0 = 0; d0 < 4; ++d0)
#pragma unroll
        for (int hf = 0; hf < 2; ++hf) kf[2 * d0 + hf] = *(const bf16x8*)(Kh + (size_t)(kr * 64 + 32 * hf + r32) * D + 16 * d0 + 8 * hi);
}
__device__ __forceinline__ void wg_task(int b, int h, int r4, const bf16* Q, const bf16* K, const bf16* V, bf16* O, const float* rpb_h, LAS unsigned char* lds, int wave, int lane, int tid) {
    LAS float* tabr = (LAS float*)(lds + TAB_OFF);
    __syncthreads();
    if (tid < NTAB) tabr[TAB_PAD + tid] = rpb_h[tid] * LOG2E;
    __syncthreads();
    const int r32 = lane & 31, hi = lane >> 5, qb = wave & 1;
    const int r = r4 * 4 + (wave >> 1), rs = min(max(r - 4, 0), 56);
    const size_t rowbase = (size_t)b * SEQ;
    const bf16* Kh = K + rowbase * D + h * 64; const bf16* Vh = V + rowbase * D + h * 64;
    LAS unsigned char* vbuf = lds + RING_OFF + wave * 16384;
    issue_v(Vh, rs, vbuf, lane);
    bf16x8 kf[8]; load_k(kf, Kh, rs, r32, hi);
    const int cq = 32 * qb + r32, cs = min(max(cq - 8, 0), 48), lo = cs - 4 * hi, lp = 4 * hi - cq + 15;
    bf16x8 qr[4];
#pragma unroll
    for (int d0 = 0; d0 < 4; ++d0) qr[d0] = *(const bf16x8*)(Q + (rowbase + r * 64 + cq) * D + h * 64 + 16 * d0 + 8 * hi);
    f32x16 o[2];
#pragma unroll
    for (int db = 0; db < 2; ++db)
#pragma unroll
        for (int e = 0; e < 16; ++e) o[db][e] = 0.f;
    float m = -1e30f, l = 0.f;
    for (int i = 0; i < 8; ++i) {
        const int kr = rs + i;
        asm volatile("s_waitcnt vmcnt(0)" ::: "memory");
        if (i + 1 < 8) issue_v(Vh, kr + 1, vbuf + ((i + 1) & 1) * 8192, lane);
        const LAS float* tp = tabr + TAB_PAD + (kr - r + 7) * 31 + lp;
        f32x16 p0, p1;
#pragma unroll
        for (int e = 0; e < 16; ++e) { p0[e] = 0.f; p1[e] = 0.f; }
#pragma unroll
        for (int d0 = 0; d0 < 4; ++d0) {
            p0 = __builtin_amdgcn_mfma_f32_32x32x16_bf16(kf[2 * d0], qr[d0], p0, 0, 0, 0);
            p1 = __builtin_amdgcn_mfma_f32_32x32x16_bf16(kf[2 * d0 + 1], qr[d0], p1, 0, 0, 0);
        }
        if (i + 1 < 8) load_k(kf, Kh, kr + 1, r32, hi);
        float rm = -1e30f;
#pragma unroll
        for (int e = 0; e < 16; ++e) { const int cst = (e & 3) + 8 * (e >> 2);
            const bool v0 = (unsigned)(cst - lo) <= 15u, v1 = (unsigned)(cst + 32 - lo) <= 15u;
            const float s0 = p0[e] + tp[cst], s1 = p1[e] + tp[cst + 32];
            p0[e] = v0 ? s0 : -1e30f; p1[e] = v1 ? s1 : -1e30f;
            rm = __builtin_fmaxf(rm, __builtin_fmaxf(p0[e], p1[e])); }
        rm = __builtin_fmaxf(rm, __shfl_xor(rm, 32));
        const bool grow = rm > m + da::THR;
        if (__any(grow)) {
            const float mn = grow ? rm : m; const float al = __builtin_amdgcn_exp2f(m - mn); l *= al; m = mn;
#pragma unroll
            for (int db = 0; db < 2; ++db)
#pragma unroll
                for (int e = 0; e < 16; ++e) o[db][e] *= al;
        }
        float ps = 0.f;
#pragma unroll
        for (int e = 0; e < 16; ++e) { p0[e] = __builtin_amdgcn_exp2f(p0[e] - m); p1[e] = __builtin_amdgcn_exp2f(p1[e] - m); ps += p0[e] + p1[e]; }
        l += ps;
        bf16x8 pb[4]; pb[0] = da::pack8(p0, 0); pb[1] = da::pack8(p0, 8); pb[2] = da::pack8(p1, 0); pb[3] = da::pack8(p1, 8);
        const LAS unsigned char* vb = vbuf + (i & 1) * 8192 + (4 * hi + ((lane & 15) >> 2)) * 64 + ((lane >> 4) & 1) * 32 + (lane & 3) * 8;
#pragma unroll
        for (int db = 0; db < 2; ++db)
#pragma unroll
            for (int ks = 0; ks < 4; ++ks) {
                const s16x4 lw = da::vtr(vb + db * 4096 + ks * 1024), hh = da::vtr(vb + db * 4096 + ks * 1024 + 512);
                const bf16x8 vf = (bf16x8){lw[0], lw[1], lw[2], lw[3], hh[0], hh[1], hh[2], hh[3]};
                o[db] = __builtin_amdgcn_mfma_f32_32x32x16_bf16(vf, pb[ks], o[db], 0, 0, 0);
            }
    }
    l += __shfl_xor(l, 32); const float inv = 1.f / l;
    bf16* orow = O + (rowbase + r * 64 + cq) * D + h * 64;
#pragma unroll
    for (int db = 0; db < 2; ++db)
#pragma unroll
        for (int g4 = 0; g4 < 4; ++g4) { const int d = 32 * db + 8 * g4 + 4 * hi;
            u32x2v w; w.x = da::cvtpk(o[db][4 * g4] * inv, o[db][4 * g4 + 1] * inv); w.y = da::cvtpk(o[db][4 * g4 + 2] * inv, o[db][4 * g4 + 3] * inv);
            *(u32x2v*)(orow + d) = w; }
}
}
__device__ __forceinline__ void ph_na_attn(const Args& a, Frame& F, int L) {
    const int j = L >> 1;
    const float* rpb = a.in[7] + (size_t)j * 16 * na::NTAB;
    const bf16* Q = (const bf16*)(a.ws + WS_Q); const bf16* K = (const bf16*)(a.ws + WS_K); const bf16* V = (const bf16*)(a.ws + WS_V); bf16* O = (bf16*)(a.ws + WS_O);
    for (int wt = F.vcu; wt < BATCH * 16 * 16; wt += F.G) {
        const int r4 = wt & 15, h = (wt >> 4) & 15, b = wt >> 8;
        na::wg_task(b, h, r4, Q, K, V, O, rpb + (size_t)h * na::NTAB, F.lds, F.wave, F.lane, F.tid);
    }
}

__device__ __forceinline__ void naive_na_attn(const Args& a, Frame& F, int L) {
    const int gw = F.vcu * NWAVES + F.wave, NGW = F.G * NWAVES, lane = F.lane;
    const int j = L >> 1;
    const float* rpb = a.in[7] + (size_t)j * 16 * 15 * 31;
    const bf16* Q = (const bf16*)(a.ws + WS_Q); const bf16* K = (const bf16*)(a.ws + WS_K); const bf16* V = (const bf16*)(a.ws + WS_V); bf16* O = (bf16*)(a.ws + WS_O);
    LAS float* qs = (LAS float*)(F.lds + RING_OFF) + F.wave * 128;
    for (int task = gw; task < M * 16; task += NGW) {
        const int h = task & 15, row = task >> 4, b = row / SEQ, t = row % SEQ, r = t >> 6, c = t & 63;
        const int rs = min(max(r - 4, 0), 56), cs = min(max(c - 8, 0), 48);
        qs[lane] = bf2f(Q[(size_t)row * D + h * 64 + lane]);
        LDS_WAIT(); asm volatile("" ::: "memory");
        const bf16* Kb = K + (size_t)b * SEQ * D + h * 64; const bf16* Vb = V + (size_t)b * SEQ * D + h * 64;
        float sc[2];
#pragma unroll
        for (int hf = 0; hf < 2; ++hf) {
            const int kk = lane + 64 * hf, i = kk >> 4, jj = kk & 15, kt = (rs + i) * 64 + cs + jj;
            const bf16* kp = Kb + (size_t)kt * D; float acc = 0.f;
#pragma unroll
            for (int cc = 0; cc < 8; ++cc) { const bf16x8 kv = *(const bf16x8*)(kp + cc * 8);
#pragma unroll
                for (int e = 0; e < 8; ++e) acc += qs[cc * 8 + e] * bf2f((unsigned short)kv[e]); }
            sc[hf] = acc + rpb[((size_t)h * 15 + (rs + i - r + 7)) * 31 + (cs + jj - c + 15)] * LOG2E;
        }
        const float mx = wave_max(fmaxf(sc[0], sc[1]));
        const float p0 = exp2f(sc[0] - mx), p1 = exp2f(sc[1] - mx);
        const float inv = 1.f / wave_sum(p0 + p1);
        float o = 0.f;
#pragma unroll 8
        for (int kk = 0; kk < 128; ++kk) { const int i = kk >> 4, jj = kk & 15, kt = (rs + i) * 64 + cs + jj;
            const float pk = __shfl(kk < 64 ? p0 : p1, kk & 63); o += pk * bf2f(Vb[(size_t)kt * D + lane]); }
        O[(size_t)row * D + h * 64 + lane] = (bf16)f2bf(o * inv);
        asm volatile("" ::: "memory");
    }
}

template <int S> __device__ __forceinline__ void run_phase(const Args& args, Frame& F0, int L) {
    Frame F = F0; { int t_ = threadIdx.x; asm volatile("" : "+v"(t_)); F.tid = t_; F.lane = t_ & 63; F.wave = __builtin_amdgcn_readfirstlane(t_ >> 6); }
    const int j = L >> 1; const bool na = (L & 1) != 0;
    bf16* WQKV = (bf16*)(args.ws + WS_WQKV); bf16* WO = (bf16*)(args.ws + WS_WO); bf16* WIN = (bf16*)(args.ws + WS_WIN); bf16* WOUT = (bf16*)(args.ws + WS_WOUT);
    bf16* XB = (bf16*)(args.ws + WS_XB); bf16* ACT = (bf16*)(args.ws + WS_ACT); bf16* HB = (bf16*)(args.ws + WS_H);
    bf16* QB = (bf16*)(args.ws + WS_Q); bf16* OB = (bf16*)(args.ws + WS_O); float* Y = (float*)(args.ws + WS_Y);
    if constexpr (S == 0) ph_convert(args, F, L);
    else if constexpr (S == 1) {
        pg8::Gemm g{XB, WQKV, M, NQKV, D}; pg8::StaticOrder So; So.init(M, NQKV, F.G, (int)blockIdx.x);
        pg8::EpiBf16<0> E{QB, D, na ? args.in[6] + (size_t)j * NQKV : nullptr, D, (size_t)(WS_K - WS_Q) / 2, QSCALE, na ? nullptr : (unsigned*)(args.ws + WS_CTL) + CW_NRM + j * 256, SEQ};
        pg8::gemm_phase<pg8::EpiBf16<0>, pg8::StaticOrder, PG8_ALIGN, PG8_SP2>(F.lds + RING_OFF, g, So, E);
    }
    else if constexpr (S == 2) { if (na) {
#if NAIVE_NA
        naive_na_attn(args, F, L);
#else
        ph_na_attn(args, F, L);
#endif
    } else {
#if NAIVE_DIFF
        naive_diff_attn(args, F, L);
#else
        ph_diff_attn(args, F, L);
#endif
    } }
    else if constexpr (S == 3) {
        pg8::Gemm g{OB, WO, M, D, D}; pg8::StaticOrder So; So.init(M, D, F.G, (int)blockIdx.x);
        pg8::EpiF32 E{Y, D, na ? args.in[9] + (size_t)j * D : nullptr};
        pg8::gemm_phase<pg8::EpiF32, pg8::StaticOrder, PG8_ALIGN, PG8_SP2>(F.lds + RING_OFF, g, So, E);
    }
    else if constexpr (S == 4) ph_ln(args, F, L, 0);
    else if constexpr (S == 5) {
        pg8::Gemm g{XB, WIN, M, FF2, D}; pg8::StaticOrder So; So.init(M, FF2, F.G, (int)blockIdx.x);
        pg8::EpiBf16<0> E{HB, FF2, args.in[11] + (size_t)L * FF2, 0, 0, 1.f, nullptr, SEQ};
        pg8::gemm_phase<pg8::EpiBf16<0>, pg8::StaticOrder, PG8_ALIGN, PG8_SP2>(F.lds + RING_OFF, g, So, E);
    }
    else if constexpr (S == 6) ph_conv(args, F, L);
    else if constexpr (S == 7) {
        pg8::Gemm g{ACT, WOUT, M, D, FF}; pg8::StaticOrder So; So.init(M, D, F.G, (int)blockIdx.x);
        pg8::EpiF32 E{Y, D, args.in[15] + (size_t)L * D};
        pg8::gemm_phase<pg8::EpiF32, pg8::StaticOrder, PG8_ALIGN, PG8_SP2>(F.lds + RING_OFF, g, So, E);
    }
    else ph_ln(args, F, L, 1);
}
__device__ __forceinline__ void frame_init(Frame& F, const Args& args, unsigned char* lds) {
    F.lds = (LAS unsigned char*)lds;
    F.MISC = (volatile LAS unsigned*)(F.lds + MISC_OFF);
    F.tid = threadIdx.x; F.lane = F.tid & 63; F.wave = __builtin_amdgcn_readfirstlane(F.tid >> 6);
    F.G = gridDim.x; { const int bx = blockIdx.x; F.vcu = (F.G % 8 == 0) ? (bx % 8) * (F.G / 8) + bx / 8 : bx; }
    F.ctl = (gu32*)(args.ws + WS_CTL);
}
template <int S> __global__ void __launch_bounds__(NWAVES * 64, 2) phase_kernel(Args args) {
    extern __shared__ __attribute__((aligned(16))) unsigned char lds[];
    Frame F; frame_init(F, args, lds);
    run_phase<S>(args, F, args.ph_lo);
}

__global__ void __launch_bounds__(NWAVES * 64, 2) fwd_kernel(Args args) {
    extern __shared__ __attribute__((aligned(16))) unsigned char lds[];
    Frame F; frame_init(F, args, lds);
    for (int u = F.tid; u < (LDS_BYTES - LDSCTL_OFF) / 4; u += NWAVES * 64) ((LAS unsigned*)(F.lds + LDSCTL_OFF))[u] = 0u;
    __syncthreads();
    XcdBarrier bar = xcd_barrier_post((unsigned*)(F.ctl + CW_BAR), F.MISC + 8);
    const int lo = args.ph_lo, hi = args.ph_hi;
    for (int p = lo; p < hi; ++p) {
        const int L = p / PH_PER_LAYER, s = p % PH_PER_LAYER;
        switch (s) {
            case 0: run_phase<0>(args, F, L); break;
            case 1: run_phase<1>(args, F, L); break;
            case 2: run_phase<2>(args, F, L); break;
            case 3: run_phase<3>(args, F, L); break;
            case 4: run_phase<4>(args, F, L); break;
            case 5: run_phase<5>(args, F, L); break;
            case 6: run_phase<6>(args, F, L); break;
            case 7: run_phase<7>(args, F, L); break;
            default: run_phase<8>(args, F, L); break;
        }
        if (p + 1 < hi) xcd_barrier(bar);
#if defined(REP_MASK)
#ifndef REP_ATT
#define REP_ATT 0
#endif
        if ((((REP_MASK) >> s) & 1) && (s != 2 || REP_ATT == 0 || (REP_ATT == 1 && (L & 1) == 0) || (REP_ATT == 2 && (L & 1) == 1))) {
            switch (s) {
                case 0: run_phase<0>(args, F, L); break;
                case 1: run_phase<1>(args, F, L); break;
                case 2: run_phase<2>(args, F, L); break;
                case 3: run_phase<3>(args, F, L); break;
                case 5: run_phase<5>(args, F, L); break;
                case 6: run_phase<6>(args, F, L); break;
                default: run_phase<7>(args, F, L); break;
            }
            xcd_barrier(bar);
        }
#endif
    }
}

template <int S> static void launch_phase(int grid, Args a, int L, hipStream_t stream) {
    static bool attr = false;
    if (!attr) { (void)hipFuncSetAttribute((const void*)phase_kernel<S>, hipFuncAttributeMaxDynamicSharedMemorySize, LDS_BYTES); attr = true; }
    a.ph_lo = L; a.ph_hi = S;
    hipLaunchKernelGGL(phase_kernel<S>, dim3(grid), dim3(NWAVES * 64), LDS_BYTES, stream, a);
}
extern "C" void kernel_launch(void* const* d_in, const int* in_sizes, int n_in, void* d_out, int out_size, void* d_ws, size_t ws_size, hipStream_t stream) {
    static int grid = 0;
    if (grid == 0) {
        if (n_in != 18 || in_sizes[0] != M * D || out_size != M * D || ws_size < WS_END) { fprintf(stderr, "kernel_launch: unexpected shapes (n_in %d, in0 %d, out %d, ws %zu)\n", n_in, n_in > 0 ? in_sizes[0] : -1, out_size, ws_size); grid = -1; return; }
        int dev = 0, cus = 0;
        if (hipGetDevice(&dev) != hipSuccess || hipDeviceGetAttribute(&cus, hipDeviceAttributeMultiprocessorCount, dev) != hipSuccess) { grid = -1; return; }
        grid = cus;
    }
    if (grid < 0) return;
    (void)hipMemsetAsync((char*)d_ws + WS_CTL, 0, CTL_ZERO_BYTES, stream);
    Args a{};
    for (int i = 0; i < 18; ++i) a.in[i] = (const float*)d_in[i];
    a.out = (float*)d_out; a.ws = (unsigned char*)d_ws;
#if MK_ONE_LAUNCH
    static bool attr1 = false;
    if (!attr1) { (void)hipFuncSetAttribute((const void*)fwd_kernel, hipFuncAttributeMaxDynamicSharedMemorySize, LDS_BYTES); attr1 = true; }
    a.ph_lo = 0; a.ph_hi = N_PHASES;
    hipLaunchKernelGGL(fwd_kernel, dim3(grid), dim3(NWAVES * 64), LDS_BYTES, stream, a);
#else
    for (int L = 0; L < DEPTH; ++L) {
        launch_phase<0>(grid, a, L, stream); launch_phase<1>(grid, a, L, stream); launch_phase<2>(grid, a, L, stream);
        launch_phase<3>(grid, a, L, stream); launch_phase<4>(grid, a, L, stream); launch_phase<5>(grid, a, L, stream);
        launch_phase<6>(grid, a, L, stream); launch_phase<7>(grid, a, L, stream); launch_phase<8>(grid, a, L, stream);
    }
#endif
}
```
